# Optimizing an MI355X kernel written in HIP

```python
import math
import jax, jax.numpy as jnp
from jax import lax
import numpy as np

D_MODEL = 1024
BATCH = 8
SEQ = 2048
DEPTH = 4

N_A = DEPTH // 2
N_B = DEPTH - N_A
D_FF = 4 * D_MODEL
CONV_WIDTH = 31
HEAD_DIM = 64
N_HEADS = D_MODEL // (2 * HEAD_DIM)
QK_DIM = 2 * N_HEADS * HEAD_DIM
V_DIM = N_HEADS * 2 * HEAD_DIM
NUM_BUCKETS = 32
MAX_DISTANCE = 128
PLE_DIM = 256
Q_BLOCK = 128
RMS_EPS = 1e-6
LN_EPS = 1e-5
NEG_INF = -1e30

kernel_name = "yoco_conformer_diffattn_macaron"


def rms_norm(x, g, eps=RMS_EPS):
    xf = x.astype(jnp.float32)
    y = xf * lax.rsqrt(jnp.mean(xf * xf, axis=-1, keepdims=True) + eps)
    return (y * g.astype(jnp.float32)).astype(x.dtype)


def layer_norm(x, g, b, eps=LN_EPS):
    xf = x.astype(jnp.float32)
    mu = jnp.mean(xf, axis=-1, keepdims=True)
    var = jnp.mean(jnp.square(xf - mu), axis=-1, keepdims=True)
    y = (xf - mu) * lax.rsqrt(var + eps) * g.astype(jnp.float32) + b.astype(jnp.float32)
    return y.astype(x.dtype)


def swiglu_ffn(h, w_in, w_out):
    g, u = jnp.split(h @ w_in, 2, axis=-1)
    return (jax.nn.silu(g) * u) @ w_out


def conformer_conv(h, w_in, b_in, w_dw, b_dw, ln_g, ln_b, w_out, b_out):
    a, gate = jnp.split(h @ w_in + b_in, 2, axis=-1)
    u = a * jax.nn.sigmoid(gate)
    u = lax.conv_general_dilated(
        u, w_dw[:, None, :].astype(u.dtype), window_strides=(1,),
        padding=((CONV_WIDTH - 1, 0),),
        dimension_numbers=("NWC", "WIO", "NWC"),
        feature_group_count=D_MODEL) + b_dw
    u = jax.nn.silu(layer_norm(u, ln_g, ln_b))
    return u @ w_out + b_out


def rel_bucket(q_pos, k_pos):
    n = jnp.maximum(q_pos[:, None] - k_pos[None, :], 0)
    max_exact = NUM_BUCKETS // 2
    nf = jnp.maximum(n, 1).astype(jnp.float32)
    large = max_exact + (jnp.log(nf / max_exact) / math.log(MAX_DISTANCE / max_exact)
                         * (NUM_BUCKETS - max_exact)).astype(jnp.int32)
    large = jnp.minimum(large, NUM_BUCKETS - 1)
    return jnp.where(n < max_exact, n, large)


def diff_attention(h, k, v, w_q, lq1, lk1, lq2, lk2, subln, w_o, rel_bias, lambda_init):
    B, S, _ = h.shape
    nb = S // Q_BLOCK
    scale = HEAD_DIM ** -0.5
    q = (h @ w_q).reshape(B, nb, Q_BLOCK, 2, N_HEADS, HEAD_DIM).transpose(1, 0, 2, 3, 4, 5)
    k1, k2 = k[:, :, 0], k[:, :, 1]
    f32 = jnp.float32
    lam = (jnp.exp(jnp.sum(lq1.astype(f32) * lk1.astype(f32)))
           - jnp.exp(jnp.sum(lq2.astype(f32) * lk2.astype(f32))) + lambda_init)
    k_pos = jnp.arange(S)

    def block(args):
        i, qblk = args
        q_pos = i * Q_BLOCK + jnp.arange(Q_BLOCK)
        bias = rel_bias[rel_bucket(q_pos, k_pos)].astype(f32).transpose(2, 0, 1)
        mask = k_pos[None, :] <= q_pos[:, None]

        def probs(qh, kh):
            s = jnp.einsum("bqhd,bkhd->bhqk", qh, kh).astype(f32) * scale + bias
            return jax.nn.softmax(jnp.where(mask, s, NEG_INF), axis=-1)

        a = probs(qblk[:, :, 0], k1) - lam * probs(qblk[:, :, 1], k2)
        return jnp.einsum("bhqk,bkhe->bqhe", a, v)

    o = lax.map(block, (jnp.arange(nb), q))
    o = o.transpose(1, 0, 2, 3, 4).reshape(B, S, N_HEADS, 2 * HEAD_DIM)
    o = rms_norm(o, subln) * (1.0 - lambda_init)
    return o.reshape(B, S, V_DIM).astype(h.dtype) @ w_o


def setup_inputs(seed: int = 0) -> dict:
    key = jax.random.key(seed)
    ks = iter(jax.random.split(key, 48))
    f32 = jnp.float32

    def nrm(shape, fan_in):
        return jax.random.normal(next(ks), shape, f32) * (fan_in ** -0.5)

    def gain(shape):
        return 1.0 + 0.02 * jax.random.normal(next(ks), shape, f32)

    def small(shape, s=0.02):
        return s * jax.random.normal(next(ks), shape, f32)

    return {
        "x": jax.random.normal(next(ks), (BATCH, SEQ, D_MODEL), f32),
        "p": jax.random.normal(next(ks), (DEPTH, BATCH, SEQ, PLE_DIM), f32),
        "ffn1_norm": gain((DEPTH, D_MODEL)),
        "ffn1_w_in": nrm((DEPTH, D_MODEL, 2 * D_FF), D_MODEL),
        "ffn1_w_out": nrm((DEPTH, D_FF, D_MODEL), D_FF),
        "mix_norm": gain((DEPTH, D_MODEL)),
        "ffn2_norm": gain((DEPTH, D_MODEL)),
        "ffn2_w_in": nrm((DEPTH, D_MODEL, 2 * D_FF), D_MODEL),
        "ffn2_w_out": nrm((DEPTH, D_FF, D_MODEL), D_FF),
        "ple_norm": gain((DEPTH, D_MODEL)),
        "ple_w_gate": nrm((DEPTH, D_MODEL, D_MODEL), D_MODEL),
        "ple_w_proj": nrm((DEPTH, PLE_DIM, D_MODEL), PLE_DIM),
        "conv_w_in": nrm((N_A, D_MODEL, 2 * D_MODEL), D_MODEL),
        "conv_b_in": small((N_A, 2 * D_MODEL)),
        "conv_w_dw": nrm((N_A, CONV_WIDTH, D_MODEL), CONV_WIDTH),
        "conv_b_dw": small((N_A, D_MODEL)),
        "conv_ln_g": gain((N_A, D_MODEL)),
        "conv_ln_b": small((N_A, D_MODEL)),
        "conv_w_out": nrm((N_A, D_MODEL, D_MODEL), D_MODEL),
        "conv_b_out": small((N_A, D_MODEL)),
        "kv_norm": gain((D_MODEL,)),
        "w_kv": nrm((D_MODEL, QK_DIM + V_DIM), D_MODEL),
        "attn_w_q": nrm((N_B, D_MODEL, QK_DIM), D_MODEL),
        "attn_lq1": small((N_B, HEAD_DIM), 0.1),
        "attn_lk1": small((N_B, HEAD_DIM), 0.1),
        "attn_lq2": small((N_B, HEAD_DIM), 0.1),
        "attn_lk2": small((N_B, HEAD_DIM), 0.1),
        "attn_subln": gain((N_B, 2 * HEAD_DIM)),
        "attn_w_o": nrm((N_B, V_DIM, D_MODEL), V_DIM),
        "rel_bias": small((NUM_BUCKETS, N_HEADS), 0.5),
        "final_norm": gain((D_MODEL,)),
    }


def reference(x, p, ffn1_norm, ffn1_w_in, ffn1_w_out, mix_norm, ffn2_norm, ffn2_w_in, ffn2_w_out,
              ple_norm, ple_w_gate, ple_w_proj, conv_w_in, conv_b_in, conv_w_dw, conv_b_dw,
              conv_ln_g, conv_ln_b, conv_w_out, conv_b_out, kv_norm, w_kv, attn_w_q,
              attn_lq1, attn_lk1, attn_lq2, attn_lk2, attn_subln, attn_w_o, rel_bias, final_norm):
    B, S, _ = x.shape
    h = x
    k_shared = None
    v_shared = None
    for i in range(DEPTH):
        if i == N_A:
            kv = rms_norm(h, kv_norm) @ w_kv
            k_shared = kv[..., :QK_DIM].reshape(B, S, 2, N_HEADS, HEAD_DIM)
            v_shared = kv[..., QK_DIM:].reshape(B, S, N_HEADS, 2 * HEAD_DIM)
        h = h + 0.5 * swiglu_ffn(rms_norm(h, ffn1_norm[i]), ffn1_w_in[i], ffn1_w_out[i])
        hn = rms_norm(h, mix_norm[i])
        if i < N_A:
            h = h + conformer_conv(hn, conv_w_in[i], conv_b_in[i], conv_w_dw[i], conv_b_dw[i],
                                   conv_ln_g[i], conv_ln_b[i], conv_w_out[i], conv_b_out[i])
        else:
            j = i - N_A
            lambda_init = 0.8 - 0.6 * math.exp(-0.3 * i)
            h = h + diff_attention(hn, k_shared, v_shared, attn_w_q[j], attn_lq1[j], attn_lk1[j],
                                   attn_lq2[j], attn_lk2[j], attn_subln[j], attn_w_o[j],
                                   rel_bias, lambda_init)
        h = h + 0.5 * swiglu_ffn(rms_norm(h, ffn2_norm[i]), ffn2_w_in[i], ffn2_w_out[i])
        gate = jax.nn.sigmoid(rms_norm(h, ple_norm[i]) @ ple_w_gate[i])
        h = h + gate * (p[i] @ ple_w_proj[i])
    return rms_norm(h, final_norm)
```

```cpp
#include <hip/hip_runtime.h>
#include <hip/hip_cooperative_groups.h>
#include <cstdio>
#include <cstdint>
#include <cmath>
namespace cg = cooperative_groups;
namespace pg8 {
#define PG8_LAS __attribute__((address_space(3)))
typedef unsigned short bf16_t;
typedef short bf16x8 __attribute__((ext_vector_type(8)));
typedef float f32x4 __attribute__((ext_vector_type(4)));
typedef unsigned u32x4 __attribute__((ext_vector_type(4)));
constexpr int BM = 256, BK = 64, HALF = 128, HTB = HALF * BK * 2  , STAGE_BYTES = 8 * HTB, NXCD = 8, WGM = 8;

__host__ __device__ __forceinline__ int lds_byte(int r, int c) { const int st = (r >> 4) * 2 + (c >> 5), rr = r & 15, cc = c & 31, ob = rr * 64 + cc * 2; return st * 1024 + (ob ^ (((ob >> 9) & 1) << 5)); }
__host__ __device__ __forceinline__ void stage_rc(int b, int& R, int& C) { const int st = b / 1024, sb = b % 1024, swz = sb ^ (((sb >> 9) & 1) << 5); R = (st >> 1) * 16 + swz / 64; C = (st & 1) * 32 + (swz % 64) / 2; }
__host__ __device__ __forceinline__ int perm32(int rho) { const int n = rho >> 4, i = rho & 15; return 8 * (i >> 2) + 4 * n + (i & 3); }

struct Unit { int pm, pn; };
struct Gemm { const bf16_t* A; const bf16_t* Bt; int M, N, K; };

struct StaticOrder {
    int nM, nN, nwg, G, c;
    __host__ __device__ void init(int M, int N, int G_, int c_) { nM = M / BM; nN = N / BM; nwg = nM * nN; G = G_; c = c_; }
    __host__ __device__ bool next(int i, Unit& u) const {
        const long L = (long)i * G + c; if (L >= nwg) return false;
        int wgid = (int)L; { const int q = nwg / NXCD, r = nwg % NXCD, xcd = wgid % NXCD, off = wgid / NXCD; wgid = (xcd < r ? xcd * (q + 1) : r * (q + 1) + (xcd - r) * q) + off; }
        const int nig = WGM * nN, gid = wgid / nig, fm = gid * WGM, gsz = (nM - fm) < WGM ? (nM - fm) : WGM;
        u.pm = fm + ((wgid % nig) % gsz); u.pn = (wgid % nig) / gsz; return true;
    }
    __device__ __forceinline__ void a_ready(const Unit&) const {}
    __device__ __forceinline__ void done(const Unit&) const {}
};


typedef float f32x2 __attribute__((ext_vector_type(2)));
typedef unsigned u32x2 __attribute__((ext_vector_type(2)));
__device__ __forceinline__ unsigned cvt_pk_bf16(float lo, float hi) {
    typedef __bf16 bf16x2_t __attribute__((ext_vector_type(2)));
    f32x2 v = {lo, hi}; bf16x2_t b = __builtin_convertvector(v, bf16x2_t); return __builtin_bit_cast(unsigned, b);
}
__device__ __forceinline__ float sigmoid_f(float x) { return __builtin_amdgcn_rcpf(1.0f + __builtin_amdgcn_exp2f(-1.4426950408889634f * x)); }
__device__ __forceinline__ float row_rstd(const float* ssq, int row) {
    const f32x4* p = (const f32x4*)(ssq + (size_t)row * 16);
    const f32x4 a = p[0], b = p[1], c = p[2], d = p[3];
    const float s = (((a[0] + a[1]) + (a[2] + a[3])) + ((b[0] + b[1]) + (b[2] + b[3]))) + (((c[0] + c[1]) + (c[2] + c[3])) + ((d[0] + d[1]) + (d[2] + d[3])));
    return 1.0f / sqrtf(s * (1.0f / 1024.0f) + 1e-6f);
}

__device__ __forceinline__ float xor_lane(float v, int lane, int mask) { return __int_as_float(__builtin_amdgcn_ds_bpermute((lane ^ mask) << 2, __float_as_int(v))); }
__device__ __forceinline__ float row_rstd_d(const float* ssq, int row, int lane) {
    const f32x4 a = *(const f32x4*)(ssq + (size_t)row * 16 + 4 * (lane >> 4));
    float s = (a[0] + a[1]) + (a[2] + a[3]);
    s += xor_lane(s, lane, 16); s += xor_lane(s, lane, 32);
    return __builtin_amdgcn_rsqf(s * (1.0f / 1024.0f) + 1e-6f);
}

__device__ __forceinline__ void rows_rstd8(const float* ssq, int row0, int lane, float (&o)[8]) {
    f32x4 a[8];
#pragma unroll
    for (int g = 0; g < 8; ++g) a[g] = *(const f32x4*)(ssq + (size_t)(row0 + (g >> 2) * HALF + (g & 3) * 16) * 16 + 4 * (lane >> 4));
    asm volatile("" ::: "memory");
#pragma unroll
    for (int g = 0; g < 8; ++g) { float s = (a[g][0] + a[g][1]) + (a[g][2] + a[g][3]); s += xor_lane(s, lane, 16); s += xor_lane(s, lane, 32); o[g] = __builtin_amdgcn_rsqf(s * (1.0f / 1024.0f) + 1e-6f); }
}

template <int MODE> struct EpiGlu {
    static constexpr bool PERM = true, AFTER_DRAIN = false;
    bf16_t* O; int ldc; const float* ssq; const float* bias; int bias_half;
    __device__ __forceinline__ void row_pre(const Unit& u, int wr_, float (&o)[8]) const {
        int l_; asm volatile("v_mbcnt_lo_u32_b32 %0, -1, 0\n\tv_mbcnt_hi_u32_b32 %0, -1, %0" : "=v"(l_));
        const int row0 = u.pm * BM + __builtin_amdgcn_readfirstlane(wr_) * 64 + (l_ & 15);
        rows_rstd8(ssq, row0, l_, o);
    }
    __device__ __forceinline__ void operator()(const f32x4 (&acc)[2][2][4][2], const Unit& u, int wr_, int wc_, int fr_, int fq_, const float (&rpre)[8]) const {
        int l_; asm volatile("v_mbcnt_lo_u32_b32 %0, -1, 0\n\tv_mbcnt_hi_u32_b32 %0, -1, %0" : "=v"(l_));
        const int fr = l_ & 15, fq = l_ >> 4, wr = __builtin_amdgcn_readfirstlane(wr_), wc = __builtin_amdgcn_readfirstlane(wc_);
        const int row0 = u.pm * BM + wr * 64 + fr; const int j0 = u.pn * HALF + wc * 32 + 8 * fq;
        f32x4 b0[2], b1[2];
#pragma unroll
        for (int n = 0; n < 2; ++n) { b0[n] = bias ? *(const f32x4*)(bias + j0 + 4 * n) : (f32x4){0.f, 0.f, 0.f, 0.f}; b1[n] = bias ? *(const f32x4*)(bias + bias_half + j0 + 4 * n) : (f32x4){0.f, 0.f, 0.f, 0.f}; }
#pragma unroll
        for (int ai = 0; ai < 2; ++ai)
#pragma unroll
            for (int m = 0; m < 4; ++m) {
                const int row = row0 + ai * HALF + m * 16; const float rs = rpre[ai * 4 + m];
                float o[8];
                if (MODE == 0) {
                    const float nrl = rs * -1.4426950408889634f, rs2 = rs * rs;
#pragma unroll
                    for (int n = 0; n < 2; ++n)
#pragma unroll
                        for (int h2 = 0; h2 < 2; ++h2) {
                            const f32x2 g2 = {acc[ai][0][m][n][2 * h2], acc[ai][0][m][n][2 * h2 + 1]}, u2 = {acc[ai][1][m][n][2 * h2], acc[ai][1][m][n][2 * h2 + 1]};
                            const f32x2 a2 = g2 * nrl; f32x2 d2; d2.x = __builtin_amdgcn_exp2f(a2.x); d2.y = __builtin_amdgcn_exp2f(a2.y);
                            d2 = d2 + 1.0f; f32x2 r2; r2.x = __builtin_amdgcn_rcpf(d2.x); r2.y = __builtin_amdgcn_rcpf(d2.y);
                            const f32x2 o2 = (g2 * u2) * (r2 * rs2);
                            o[4 * n + 2 * h2] = o2.x; o[4 * n + 2 * h2 + 1] = o2.y;
                        }
                } else {
#pragma unroll
                for (int n = 0; n < 2; ++n) {
                    const f32x4 x = acc[ai][0][m][n] * rs + b0[n], y = acc[ai][1][m][n] * rs + b1[n];
#pragma unroll
                    for (int i = 0; i < 4; ++i) o[4 * n + i] = x[i] * sigmoid_f(y[i]);
                }
                }
                u32x4 w; w.x = cvt_pk_bf16(o[0], o[1]); w.y = cvt_pk_bf16(o[2], o[3]); w.z = cvt_pk_bf16(o[4], o[5]); w.w = cvt_pk_bf16(o[6], o[7]);
                if (MODE == 0) *(u32x4*)((char*)O + ((size_t)(row >> 4) * (ldc >> 5) + (u.pn * 4 + wc)) * 1024 + (row & 15) * 64 + fq * 16) = w;
                else *(u32x4*)(O + (size_t)row * ldc + j0) = w;
            }
    }
};

struct EpiBf16Rs {
    static constexpr bool PERM = true, AFTER_DRAIN = false;
    bf16_t* O; int ldc; const float* ssq; float scale; int headmajor;
    __device__ __forceinline__ void row_pre(const Unit&, int, float (&o)[8]) const {
#pragma unroll
        for (int i = 0; i < 8; ++i) o[i] = 0.f; }
    __device__ __forceinline__ void operator()(const f32x4 (&acc)[2][2][4][2], const Unit& u, int wr_, int wc_, int fr_, int fq_, const float (&rpre)[8]) const {
        int l_; asm volatile("v_mbcnt_lo_u32_b32 %0, -1, 0\n\tv_mbcnt_hi_u32_b32 %0, -1, %0" : "=v"(l_));
        const int fr = l_ & 15, fq = l_ >> 4, wr = __builtin_amdgcn_readfirstlane(wr_), wc = __builtin_amdgcn_readfirstlane(wc_);
        const int row0 = u.pm * BM + wr * 64 + fr; const int col0 = u.pn * BM + wc * 32 + 8 * fq;
        float rs8[8];
        if (ssq) rows_rstd8(ssq, row0, l_, rs8);
        else {
#pragma unroll
            for (int g = 0; g < 8; ++g) rs8[g] = 1.0f;
        }
#pragma unroll
        for (int ai = 0; ai < 2; ++ai)
#pragma unroll
            for (int m = 0; m < 4; ++m) {
                const int row = row0 + ai * HALF + m * 16; const float rs = rs8[ai * 4 + m] * scale;
#pragma unroll
                for (int bj = 0; bj < 2; ++bj) { const f32x4 v0 = acc[ai][bj][m][0] * rs, v1 = acc[ai][bj][m][1] * rs;
                    u32x4 w; w.x = cvt_pk_bf16(v0[0], v0[1]); w.y = cvt_pk_bf16(v0[2], v0[3]); w.z = cvt_pk_bf16(v1[0], v1[1]); w.w = cvt_pk_bf16(v1[2], v1[3]);
                    const int col = col0 + bj * HALF;
                    if (headmajor) *(u32x4*)(O + ((size_t)((row >> 11) * 16 + (col >> 6)) * 2048 + (row & 2047)) * 64 + (col & 63)) = w;
                    else *(u32x4*)(O + (size_t)row * ldc + col) = w; }
            }
    }
};

struct EpiVt {
    static constexpr bool PERM = true, AFTER_DRAIN = false;
    bf16_t* O; int ldc; const float* ssq;
    __device__ __forceinline__ void row_pre(const Unit&, int, float (&o)[8]) const {
#pragma unroll
        for (int i = 0; i < 8; ++i) o[i] = 0.f; }
    __device__ __forceinline__ void operator()(const f32x4 (&acc)[2][2][4][2], const Unit& u, int wr_, int wc_, int fr_, int fq_, const float (&rpre)[8]) const {
        int l_; asm volatile("v_mbcnt_lo_u32_b32 %0, -1, 0\n\tv_mbcnt_hi_u32_b32 %0, -1, %0" : "=v"(l_));
        const int fr = l_ & 15, fq = l_ >> 4, wr = __builtin_amdgcn_readfirstlane(wr_), wc = __builtin_amdgcn_readfirstlane(wc_);
        const int row0 = u.pm * BM + wr * 64 + fr; const int col0 = u.pn * BM + wc * 32 + 8 * fq;
#pragma unroll
        for (int bj = 0; bj < 2; ++bj) {
            float rs[8];
#pragma unroll
            for (int i = 0; i < 8; ++i) rs[i] = row_rstd(ssq, col0 + bj * HALF + i);
#pragma unroll
            for (int ai = 0; ai < 2; ++ai)
#pragma unroll
                for (int m = 0; m < 4; ++m) { const int row = row0 + ai * HALF + m * 16; const f32x4 v0 = acc[ai][bj][m][0], v1 = acc[ai][bj][m][1];
                    u32x2 wa, wb; wa.x = cvt_pk_bf16(v0[0] * rs[0], v0[1] * rs[1]); wa.y = cvt_pk_bf16(v0[2] * rs[2], v0[3] * rs[3]); wb.x = cvt_pk_bf16(v1[0] * rs[4], v1[1] * rs[5]); wb.y = cvt_pk_bf16(v1[2] * rs[6], v1[3] * rs[7]);
                    const int tp = col0 + bj * HALF - 4 * (fq & 1);
                    bf16_t* p = O + ((size_t)(((tp >> 11) * 8 + (row >> 7)) * 32 + ((tp & 2047) >> 6)) * 128 + (row & 127)) * 64 + (tp & 63);
                    *(u32x2*)p = wa; *(u32x2*)(p + 8) = wb; }
        }
    }
};

__device__ __forceinline__ void unpack8(const u32x4 w, float (&f)[8]) {
    f[0] = __uint_as_float(w.x << 16); f[1] = __uint_as_float(w.x & 0xffff0000u); f[2] = __uint_as_float(w.y << 16); f[3] = __uint_as_float(w.y & 0xffff0000u);
    f[4] = __uint_as_float(w.z << 16); f[5] = __uint_as_float(w.z & 0xffff0000u); f[6] = __uint_as_float(w.w << 16); f[7] = __uint_as_float(w.w & 0xffff0000u);
}
template <int MODE> struct EpiRes {
    static constexpr bool PERM = true, AFTER_DRAIN = false;
    const bf16_t* base; bf16_t* hb; float* ssq_out; float alpha; const float* bias; const float* ssq_in; const bf16_t* pp;
    __device__ __forceinline__ void row_pre(const Unit&, int, float (&o)[8]) const {
#pragma unroll
        for (int i = 0; i < 8; ++i) o[i] = 0.f; }
    __device__ __forceinline__ void operator()(const f32x4 (&acc)[2][2][4][2], const Unit& u, int wr, int wc, int fr_, int fq_, const float (&rpre)[8]) const {
        int l_; asm volatile("v_mbcnt_lo_u32_b32 %0, -1, 0\n\tv_mbcnt_hi_u32_b32 %0, -1, %0" : "=v"(l_));
        const int fr = l_ & 15, fq = l_ >> 4;
        const int row0 = u.pm * BM + wr * 64 + fr; const int col0 = u.pn * BM + wc * 32 + 8 * fq;
        float bv[2][8];
#pragma unroll
        for (int bj = 0; bj < 2; ++bj) {
            const f32x4 b0 = (MODE == 0 && bias) ? *(const f32x4*)(bias + col0 + bj * HALF) : (f32x4){0.f, 0.f, 0.f, 0.f}, b1 = (MODE == 0 && bias) ? *(const f32x4*)(bias + col0 + bj * HALF + 4) : (f32x4){0.f, 0.f, 0.f, 0.f};
#pragma unroll
            for (int i = 0; i < 4; ++i) { bv[bj][i] = b0[i]; bv[bj][4 + i] = b1[i]; }
        }
        constexpr int GB = (MODE == 0) ? 8 : 4;
#pragma unroll
        for (int g0 = 0; g0 < 8; g0 += GB) {
            u32x4 cb[GB][2], cpw[GB][2]; float rsv[GB];
#pragma unroll
            for (int gi = 0; gi < GB; ++gi) {
                const int g = g0 + gi; const int row = row0 + (g >> 2) * HALF + (g & 3) * 16; const size_t off = (size_t)row * 1024 + col0;
#pragma unroll
                for (int bj = 0; bj < 2; ++bj) { cb[gi][bj] = *(const u32x4*)(base + off + bj * HALF); if (MODE == 1) cpw[gi][bj] = *(const u32x4*)(pp + off + bj * HALF); }
                rsv[gi] = (MODE == 1) ? row_rstd_d(ssq_in, row, l_) : 0.f;
            }
            asm volatile("" ::: "memory");
#pragma unroll
            for (int gi = 0; gi < GB; ++gi) {
                const int g = g0 + gi; const int ai = g >> 2, m = g & 3;
                const int row = row0 + ai * HALF + m * 16; const size_t off = (size_t)row * 1024 + col0;
                const float rs = rsv[gi]; float sq = 0.f;
#pragma unroll
                for (int bj = 0; bj < 2; ++bj) {
                    float b[8], p[8], v[8], rr[8]; unpack8(cb[gi][bj], b); if (MODE == 1) unpack8(cpw[gi][bj], p);
#pragma unroll
                    for (int i = 0; i < 8; ++i) { const float a = acc[ai][bj][m][i >> 2][i & 3];
                        v[i] = (MODE == 0) ? b[i] + a * alpha + bv[bj][i] : b[i] + sigmoid_f(a * rs) * p[i]; }
                    u32x4 w; w.x = cvt_pk_bf16(v[0], v[1]); w.y = cvt_pk_bf16(v[2], v[3]); w.z = cvt_pk_bf16(v[4], v[5]); w.w = cvt_pk_bf16(v[6], v[7]);
                    *(u32x4*)(hb + off + bj * HALF) = w;
                    unpack8(w, rr);
#pragma unroll
                    for (int i = 0; i < 8; i += 2) sq += rr[i] * rr[i] + rr[i + 1] * rr[i + 1];
                }
                sq += xor_lane(sq, l_, 16); sq += xor_lane(sq, l_, 32);
                if (fq == 0) ssq_out[(size_t)row * 16 + u.pn * 4 + wc] = sq;
            }
        }
    }
};
template <class Epi, class Sched, bool ALIGN_EPI = false, bool SP2 = false, bool ABLK = false  >
__device__ __forceinline__ void gemm_phase(PG8_LAS unsigned char* lds, const Gemm g, const Sched& S, const Epi& E, const int wv  ) {
    int tid_; asm volatile("v_mbcnt_lo_u32_b32 %0, -1, 0\n\tv_mbcnt_hi_u32_b32 %0, -1, %0" : "=v"(tid_)); tid_ += wv * 64;
    const int tid = tid_, wid = __builtin_amdgcn_readfirstlane(tid >> 6), lane = tid & 63, wr = wid >> 2, wc = wid & 3, fr = lane & 15, fq = lane >> 4;
    const int K = g.K, nt = K / BK;
    unsigned voffA[2], voffB[2];
#pragma unroll
    for (int i = 0; i < 2; ++i) { int R, C; stage_rc(tid * 16 + i * 8192, R, C); const int Rb = Epi::PERM ? ((R & ~31) + perm32(R & 31)) : R;
        voffA[i] = ABLK ? (unsigned)(((R >> 4) * (K >> 5) + (C >> 5)) * 1024 + (R & 15) * 64 + (C & 31) * 2) : (unsigned)(R * K + C) * 2u; voffB[i] = (unsigned)(Rb * K + C) * 2u; }
    const size_t kstepA = ABLK ? (size_t)2048 : (size_t)(BK * 2);
    const size_t kstep = (size_t)(BK * 2);
    const size_t hstep = (size_t)HALF * K * 2;
    const size_t tstep = 2 * hstep;
    const unsigned ldsw = (unsigned)wid * 1024u;
    const int aoff = lds_byte(wr * 64 + fr, fq * 8), boff = lds_byte(wc * 32 + fr, fq * 8);
#define PG8_SA(b, h) (((b) * 2 + (h)) * HTB)
#define PG8_SB(b, h) ((4 + (b) * 2 + (h)) * HTB)
#define PG8_STAGE(bufoff, gbase, voff) do { _Pragma("unroll") for (int _i = 0; _i < 2; ++_i) \
        __builtin_amdgcn_global_load_lds((const unsigned*)((const char*)(gbase) + (voff)[_i]), (PG8_LAS unsigned*)(lds + (bufoff) + ldsw + _i * 8192), 16, 0, 0); } while (0)
#define PG8_LDA(dst, b, h) do { _Pragma("unroll") for (int m = 0; m < 4; ++m) _Pragma("unroll") for (int k = 0; k < 2; ++k) dst[m][k] = *(const PG8_LAS bf16x8*)(lds + PG8_SA(b, h) + aoff + m * 2048 + k * 1024); } while (0)
#define PG8_LDB(dst, b, h) do { _Pragma("unroll") for (int n = 0; n < 2; ++n) _Pragma("unroll") for (int k = 0; k < 2; ++k) dst[n][k] = *(const PG8_LAS bf16x8*)(lds + PG8_SB(b, h) + boff + n * 2048 + k * 1024); } while (0)
#define PG8_MMA(ai, bj, At, Bt) do { __builtin_amdgcn_s_setprio(1); _Pragma("unroll") for (int m = 0; m < 4; ++m) _Pragma("unroll") for (int n = 0; n < 2; ++n) _Pragma("unroll") for (int k = 0; k < 2; ++k) \
        acc[ai][bj][m][n] = __builtin_amdgcn_mfma_f32_16x16x32_bf16(Bt[n][k], At[m][k], acc[ai][bj][m][n], 0, 0, 0); __builtin_amdgcn_s_setprio(0); } while (0)
#define PG8_WAIT_V(n) asm volatile("s_waitcnt vmcnt(" #n ")" ::: "memory")
#define PG8_WAIT_L(n) asm volatile("s_waitcnt lgkmcnt(" #n ")" ::: "memory")
#define PG8_BAR __builtin_amdgcn_s_barrier()
#define PG8_SCHED __builtin_amdgcn_sched_barrier(0)
    Unit cur, nxt; int ui = 0;
    if (!S.next(0, cur)) return;
    f32x4 acc[2][2][4][2];
#pragma unroll
    for (int a = 0; a < 2; ++a)
#pragma unroll
        for (int b = 0; b < 2; ++b)
#pragma unroll
            for (int m = 0; m < 4; ++m)
#pragma unroll
                for (int n = 0; n < 2; ++n) acc[a][b][m][n] = (f32x4){0.f, 0.f, 0.f, 0.f};
    float rpre[8];
    bf16x8 At[4][2], B0[2][2], B1[2][2];
    const char* cA = (const char*)g.A + (size_t)cur.pm * tstep; const char* cB = (const char*)g.Bt + (size_t)cur.pn * tstep;
    S.a_ready(cur);
    if constexpr (SP2) {
        PG8_STAGE(PG8_SB(0, 0), cB, voffB); PG8_STAGE(PG8_SB(0, 1), cB + hstep, voffB); PG8_STAGE(PG8_SA(0, 0), cA, voffA); PG8_STAGE(PG8_SA(0, 1), cA + hstep, voffA);
        E.row_pre(cur, wr, rpre);
        if (wr == 1) PG8_BAR;
        PG8_WAIT_V(2); PG8_BAR;
        PG8_STAGE(PG8_SB(1, 0), cB + kstep, voffB); PG8_STAGE(PG8_SA(1, 0), cA + kstepA, voffA); PG8_STAGE(PG8_SB(1, 1), cB + hstep + kstep, voffB);
        PG8_WAIT_V(6); PG8_BAR;
    } else {
        PG8_STAGE(PG8_SB(0, 0), cB, voffB); PG8_STAGE(PG8_SA(0, 0), cA, voffA); PG8_STAGE(PG8_SB(0, 1), cB + hstep, voffB); PG8_STAGE(PG8_SA(0, 1), cA + hstep, voffA);
        E.row_pre(cur, wr, rpre);
        if (wr == 1) PG8_BAR;
        PG8_WAIT_V(4); PG8_BAR;
        PG8_STAGE(PG8_SB(1, 0), cB + kstep, voffB); PG8_STAGE(PG8_SA(1, 0), cA + kstepA, voffA); PG8_STAGE(PG8_SB(1, 1), cB + hstep + kstep, voffB);
        PG8_WAIT_V(6); PG8_BAR;
    }
    for (;;) {
        const bool has_next = S.next(ui + 1, nxt);
        const char* nA = has_next ? (const char*)g.A + (size_t)nxt.pm * tstep : cA; const char* nB = has_next ? (const char*)g.Bt + (size_t)nxt.pn * tstep : cB;
        for (int t = 0; t < nt; t += 2) {
            const bool last = (t == nt - 2);
            const char* a1 = cA + (size_t)(t + 1) * kstepA;
            const char* a2 = last ? nA : cA + (size_t)(t + 2) * kstepA; const char* b2 = last ? nB : cB + (size_t)(t + 2) * kstep;
            const char* a3 = a2 + kstepA; const char* b3 = b2 + kstep;
            if (last && has_next) S.a_ready(nxt);
            if constexpr (SP2) {
            PG8_LDB(B0, 0, 0); PG8_LDB(B1, 0, 1); PG8_SCHED; PG8_LDA(At, 0, 0); PG8_STAGE(PG8_SA(1, 1), a1 + hstep, voffA);
            PG8_WAIT_V(8); PG8_WAIT_L(0); PG8_BAR; PG8_MMA(0, 0, At, B0); PG8_MMA(0, 1, At, B1); PG8_BAR; PG8_SCHED;
            PG8_LDA(At, 0, 1); PG8_STAGE(PG8_SB(0, 0), b2, voffB); PG8_STAGE(PG8_SB(0, 1), b2 + hstep, voffB); PG8_STAGE(PG8_SA(0, 0), a2, voffA);
            PG8_WAIT_V(8); PG8_WAIT_L(0); PG8_BAR; PG8_MMA(1, 0, At, B0); PG8_MMA(1, 1, At, B1); PG8_BAR; PG8_SCHED;
            PG8_LDB(B0, 1, 0); PG8_LDB(B1, 1, 1); PG8_SCHED; PG8_LDA(At, 1, 0); PG8_STAGE(PG8_SA(0, 1), a2 + hstep, voffA);
            PG8_WAIT_V(8); PG8_WAIT_L(0); PG8_BAR; PG8_MMA(0, 0, At, B0); PG8_MMA(0, 1, At, B1); PG8_BAR; PG8_SCHED;
            PG8_LDA(At, 1, 1); PG8_STAGE(PG8_SB(1, 0), b3, voffB); PG8_STAGE(PG8_SB(1, 1), b3 + hstep, voffB); PG8_STAGE(PG8_SA(1, 0), a3, voffA);
            PG8_WAIT_V(8); PG8_WAIT_L(0); PG8_BAR; PG8_MMA(1, 0, At, B0); PG8_MMA(1, 1, At, B1); PG8_BAR; PG8_SCHED;
            } else {
            PG8_LDB(B0, 0, 0); PG8_SCHED; PG8_LDA(At, 0, 0); PG8_STAGE(PG8_SA(1, 1), a1 + hstep, voffA);
            PG8_WAIT_L(8); PG8_BAR; PG8_WAIT_L(0); PG8_MMA(0, 0, At, B0); PG8_BAR; PG8_SCHED;
            PG8_LDB(B1, 0, 1); PG8_STAGE(PG8_SB(0, 0), b2, voffB);
            PG8_BAR; PG8_WAIT_L(0); PG8_MMA(0, 1, At, B1); PG8_BAR;
            PG8_LDA(At, 0, 1); PG8_STAGE(PG8_SA(0, 0), a2, voffA);
            PG8_BAR; PG8_WAIT_L(0); PG8_MMA(1, 0, At, B0); PG8_BAR; PG8_SCHED;
            PG8_STAGE(PG8_SB(0, 1), b2 + hstep, voffB);
            PG8_WAIT_V(6); PG8_BAR; PG8_MMA(1, 1, At, B1); PG8_BAR;
            PG8_LDB(B0, 1, 0); PG8_SCHED; PG8_LDA(At, 1, 0); PG8_STAGE(PG8_SA(0, 1), a2 + hstep, voffA);
            PG8_WAIT_L(8); PG8_BAR; PG8_WAIT_L(0); PG8_MMA(0, 0, At, B0); PG8_BAR; PG8_SCHED;
            PG8_LDB(B1, 1, 1); PG8_STAGE(PG8_SB(1, 0), b3, voffB);
            PG8_BAR; PG8_WAIT_L(0); PG8_MMA(0, 1, At, B1); PG8_BAR;
            PG8_LDA(At, 1, 1); PG8_STAGE(PG8_SA(1, 0), a3, voffA);
            PG8_BAR; PG8_WAIT_L(0); PG8_MMA(1, 0, At, B0); PG8_BAR; PG8_SCHED;
            PG8_STAGE(PG8_SB(1, 1), b3 + hstep, voffB);
            PG8_WAIT_V(6); PG8_BAR; PG8_MMA(1, 1, At, B1); PG8_BAR;
            }
        }
        if constexpr (ALIGN_EPI) { if (wr == 0) PG8_BAR; }
        if constexpr (!Epi::AFTER_DRAIN) {
            float rnx[8];
            if (has_next) E.row_pre(nxt, wr, rnx);
            E(acc, cur, wr, wc, fr, fq, rpre); S.done(cur);
            if (has_next) {
#pragma unroll
                for (int i = 0; i < 8; ++i) rpre[i] = rnx[i];
            }
        }
        if (!has_next) break;
#pragma unroll
        for (int a = 0; a < 2; ++a)
#pragma unroll
            for (int b = 0; b < 2; ++b)
#pragma unroll
                for (int m = 0; m < 4; ++m)
#pragma unroll
                    for (int n = 0; n < 2; ++n) acc[a][b][m][n] = (f32x4){0.f, 0.f, 0.f, 0.f};
        cur = nxt; cA = nA; cB = nB; ++ui;
        if constexpr (ALIGN_EPI) { if (wr == 1) PG8_BAR; }
    }
    PG8_WAIT_V(0);
    if constexpr (!ALIGN_EPI) { if (wr == 0) PG8_BAR; }
    PG8_BAR;
    if constexpr (Epi::AFTER_DRAIN) { E.fused(acc, cur, wr, wc, fr, fq, lds, wid, lane); S.done(cur); }
#undef PG8_SA
#undef PG8_SB
#undef PG8_STAGE
#undef PG8_LDA
#undef PG8_LDB
#undef PG8_MMA
#undef PG8_WAIT_V
#undef PG8_WAIT_L
#undef PG8_BAR
#undef PG8_SCHED
}
}

#define LAS __attribute__((address_space(3)))
typedef pg8::bf16_t bf16_t;
typedef pg8::f32x4 f32x4;
typedef pg8::u32x4 u32x4;
typedef pg8::u32x2 u32x2;
typedef pg8::bf16x8 bf16x8;
typedef float f32x16 __attribute__((ext_vector_type(16)));
typedef short s16x4 __attribute__((ext_vector_type(4)));
using pg8::cvt_pk_bf16;
using pg8::sigmoid_f;

constexpr int NWAVES = 8, NTHREADS = 512;
constexpr int BATCH = 8, SEQ = 2048, D = 1024, DFF = 4096, M = BATCH * SEQ, PLE = 256, NHEAD = 8;
constexpr int LDS_BYTES = 139264;
constexpr float LOG2E = 1.4426950408889634f;
constexpr float QSCALE = 0.125f * LOG2E;

constexpr size_t MiB = 1u << 20;
constexpr size_t WS_W = 0;
constexpr size_t W_LAYER = 50 * MiB + 512 * 1024;
constexpr size_t WL_1IN = 0, WL_1OUT = 16 * MiB, WL_2IN = 24 * MiB, WL_2OUT = 40 * MiB, WL_G = 48 * MiB, WL_P = 50 * MiB;
constexpr size_t WS_CIN = 4 * W_LAYER;
constexpr size_t WS_COUT = WS_CIN + 8 * MiB;
constexpr size_t WS_KV = WS_COUT + 4 * MiB;
constexpr size_t WS_WQ = WS_KV + 4 * MiB;
constexpr size_t WS_WO = WS_WQ + 4 * MiB;
constexpr size_t WS_HB = WS_WO + 4 * MiB;
constexpr size_t WS_U = WS_HB + 32 * MiB;
constexpr size_t WS_PB = WS_U + 128 * MiB;
constexpr size_t WS_BQ = WS_PB + 32 * MiB;
constexpr size_t WS_BO = WS_BQ + 32 * MiB;
constexpr size_t WS_KB = WS_BO + 32 * MiB;
constexpr size_t WS_VT = WS_KB + 32 * MiB;
constexpr size_t WS_SSQ = WS_VT + 33 * MiB;
constexpr size_t WS_BAR = WS_SSQ + 2 * MiB;
constexpr size_t WS_END = WS_BAR + 64 * 1024;

#define XB_TMO      128
#define XB_XCNT(j)  (256  + 64 * (j))
#define XB_XSUB(j)  (1280 + 64 * (j))
#define XB_XGEN(j)  (2304 + 64 * (j))
#define XB_TOP      3328
#define XB_TOPGEN   3392
#define XCD_BAR_WORDS 3456
#define XB_SPIN_CAP (1u << 18)

__device__ __forceinline__ unsigned xb_ld(unsigned* p)              { return __hip_atomic_load(p, __ATOMIC_RELAXED, __HIP_MEMORY_SCOPE_AGENT); }
__device__ __forceinline__ unsigned xb_add(unsigned* p, unsigned v) { return __hip_atomic_fetch_add(p, v, __ATOMIC_RELAXED, __HIP_MEMORY_SCOPE_AGENT); }
__device__ __forceinline__ unsigned xb_xcc_id() { return (unsigned)__builtin_amdgcn_s_getreg((3 << 11) | 20) & 0xFu; }
#define XB_SPIN(cond, bar) do { unsigned _sp = 0; while (cond) { __builtin_amdgcn_s_sleep(1); \
    if ((++_sp & 255u) == 0u) { if (xb_ld(&(bar)[XB_TMO])) break; if (_sp > XB_SPIN_CAP) { atomicAdd(&(bar)[XB_TMO], 1u); break; } } } } while (0)

struct XcdBarrier {
    unsigned* bar; unsigned x;
    volatile LAS unsigned* st;
};

__device__ __forceinline__ XcdBarrier xcd_barrier_post(unsigned* bar, volatile LAS unsigned* st, const bool leader) {
    XcdBarrier b; b.bar = bar; b.x = xb_xcc_id(); b.st = st;
    if (leader) (void)xb_add(&bar[XB_XCNT(b.x)], 1u);
    return b;
}
__device__ __forceinline__ void xcd_barrier_complete(unsigned* bar, unsigned x, unsigned& nloc, unsigned& nx) {
    const unsigned G = gridDim.x * gridDim.y * gridDim.z;
    unsigned sum, cnt, mine, sp = 0u;
    for (;;) {
        sum = 0u; cnt = 0u; mine = 0u;
#pragma unroll
        for (unsigned j = 0; j < 16; ++j) { const unsigned c = xb_ld(&bar[XB_XCNT(j)]); sum += c; cnt += (c > 0u) ? 1u : 0u; mine = (j == x) ? c : mine; }
        if (sum == G) break;
        __builtin_amdgcn_s_sleep(1);
        if ((++sp & 255u) == 0u) { if (xb_ld(&bar[XB_TMO])) break; if (sp > XB_SPIN_CAP) { atomicAdd(&bar[XB_TMO], 1u); break; } }
    }
    nloc = mine > 0u ? mine : 1u; nx = cnt > 0u ? cnt : 1u;
}

__device__ __forceinline__ void xcd_barrier(const XcdBarrier& b, const bool leader) {
    asm volatile("s_waitcnt vmcnt(0)" ::: "memory");
    __syncthreads();
    if (leader) {
        unsigned* bar = b.bar;
        __builtin_amdgcn_s_waitcnt(0);
        unsigned nloc = b.st[0], nx = b.st[1];
        if (nloc == 0u) { xcd_barrier_complete(bar, b.x, nloc, nx); b.st[0] = nloc; b.st[1] = nx; }
        const unsigned old = xb_add(&bar[XB_XSUB(b.x)], 1u);
        const unsigned gen = old / nloc;
        if (old + 1u == (gen + 1u) * nloc) {
            __builtin_amdgcn_fence(__ATOMIC_RELEASE, "agent");
            asm volatile("s_waitcnt vmcnt(0)" ::: "memory");
            const unsigned og = xb_add(&bar[XB_TOP], 1u);
            const unsigned tg = og / nx;
            if (og + 1u == (tg + 1u) * nx) xb_add(&bar[XB_TOPGEN], 1u);
            else XB_SPIN(xb_ld(&bar[XB_TOPGEN]) == tg, bar);
            __builtin_amdgcn_fence(__ATOMIC_ACQUIRE, "agent");
            xb_add(&bar[XB_XGEN(b.x)], 1u);
            asm volatile("s_waitcnt vmcnt(0)" ::: "memory");
        } else {
            XB_SPIN(xb_ld(&bar[XB_XGEN(b.x)]) == gen, bar);
            __builtin_amdgcn_fence(__ATOMIC_ACQUIRE, "agent");
            asm volatile("s_waitcnt vmcnt(0)" ::: "memory");
        }
    }
    __syncthreads();
}

#define XB_GCNT(g)     (3584 + 64 * (g))
#define XB_GCEN(x, g)  (4096 + 64 * ((x) * 8 + (g)))
#define XB_GGEN(g)     (12288 + 64 * (g))
#define XB_PCNT(p)     (12800 + 16 * (p))
#define XB_PGEN(p)     (13824 + 16 * (p))
#define XB_ALL_WORDS   14848
__device__ __forceinline__ void group_barrier(unsigned* bar, const int g, const bool leader) {
    asm volatile("s_waitcnt vmcnt(0)" ::: "memory");
    __syncthreads();
    if (leader) {
        __builtin_amdgcn_s_waitcnt(0);
        const unsigned old = xb_add(&bar[XB_GCNT(g)], 1u); const unsigned gen = old / 32u;
        if (old + 1u == (gen + 1u) * 32u) xb_add(&bar[XB_GGEN(g)], 1u);
        else XB_SPIN(xb_ld(&bar[XB_GGEN(g)]) == gen, bar);
        __builtin_amdgcn_fence(__ATOMIC_ACQUIRE, "agent");
        asm volatile("s_waitcnt vmcnt(0)" ::: "memory");
    }
    __syncthreads();
}
__device__ __forceinline__ void panel_barrier(unsigned* bar, const int pidx, const bool leader) {
    asm volatile("s_waitcnt vmcnt(0)" ::: "memory");
    __syncthreads();
    if (leader) {
        __builtin_amdgcn_s_waitcnt(0);
        const unsigned old = xb_add(&bar[XB_PCNT(pidx)], 1u); const unsigned gen = old >> 2;
        if (old + 1u == (gen + 1u) * 4u) xb_add(&bar[XB_PGEN(pidx)], 1u);
        else XB_SPIN(xb_ld(&bar[XB_PGEN(pidx)]) == gen, bar);
        __builtin_amdgcn_fence(__ATOMIC_ACQUIRE, "agent");
        asm volatile("s_waitcnt vmcnt(0)" ::: "memory");
    }
    __syncthreads();
}
__device__ __forceinline__ unsigned group_mode(unsigned* bar) {
    if (gridDim.x != 256) return 0u;
    unsigned tot = 0u, sp = 0u;
    for (;;) {
        tot = 0u;
        for (unsigned i = 0; i < 128; ++i) tot += xb_ld(&bar[XB_GCEN(i >> 3, i & 7)]);
        if (tot == 256u) break;
        __builtin_amdgcn_s_sleep(1);
        if ((++sp & 255u) == 0u) { if (xb_ld(&bar[XB_TMO])) break; if (sp > XB_SPIN_CAP) { atomicAdd(&bar[XB_TMO], 1u); break; } }
    }
    if (tot != 256u) return 0u;
    unsigned fast = 1u;
    for (unsigned g = 0; g < 8; ++g) { unsigned mx = 0u; for (unsigned x = 0; x < 16; ++x) { const unsigned c = xb_ld(&bar[XB_GCEN(x, g)]); mx = c > mx ? c : mx; } if (mx != 32u) fast = 0u; }
    return fast;
}

__device__ __forceinline__ float wave_sum(float v, int lane) {
#pragma unroll
    for (int o = 1; o < 64; o <<= 1) v += pg8::xor_lane(v, lane, o);
    return v;
}
__device__ __forceinline__ float swap32_add(float x) { auto rr = __builtin_amdgcn_permlane32_swap(__float_as_uint(x), __float_as_uint(x), false, false); return __uint_as_float(rr[0]) + __uint_as_float(rr[1]); }
__device__ __forceinline__ float swap32_max(float x) { auto rr = __builtin_amdgcn_permlane32_swap(__float_as_uint(x), __float_as_uint(x), false, false); return fmaxf(__uint_as_float(rr[0]), __uint_as_float(rr[1])); }

__device__ __forceinline__ void conv_weight(const float* __restrict__ W, int K, int N, const float* __restrict__ gain, int glu_half, bf16_t* __restrict__ WT, int& goff, int gw, int ngw, int lane) {
    const int nnb = N / 128, items = nnb * (K / 64);
    int first = (gw - goff) % ngw; if (first < 0) first += ngw;
    goff = (goff + items) % ngw;
    for (int it = first; it < items; it += ngw) {
        const int nb = it % nnb, kb = it / nnb; const int n = nb * 128 + 2 * lane, k0 = kb * 64;
        pg8::f32x2 v[64];
#pragma unroll
        for (int i = 0; i < 64; ++i) v[i] = *(const pg8::f32x2*)(W + (size_t)(k0 + i) * N + n);
        if (gain) {
#pragma unroll
            for (int i = 0; i < 64; ++i) v[i] *= gain[k0 + i];
        }
        int dr = n;
        if (glu_half) { const int hf = n >= glu_half ? 1 : 0; const int j = n - hf * glu_half; dr = (j >> 7) * 256 + hf * 128 + (j & 127); }
#pragma unroll
        for (int c = 0; c < 2; ++c) {
            u32x4* dst = (u32x4*)(WT + (size_t)(dr + c) * K + k0);
#pragma unroll
            for (int q = 0; q < 8; ++q) { u32x4 w; w.x = cvt_pk_bf16(v[8 * q][c], v[8 * q + 1][c]); w.y = cvt_pk_bf16(v[8 * q + 2][c], v[8 * q + 3][c]); w.z = cvt_pk_bf16(v[8 * q + 4][c], v[8 * q + 5][c]); w.w = cvt_pk_bf16(v[8 * q + 6][c], v[8 * q + 7][c]); dst[q] = w; }
        }
    }
}

__device__ __forceinline__ void dwconv_phase(LAS unsigned char* lds, const bf16_t* __restrict__ u, const float* __restrict__ w_dw, const float* __restrict__ b_dw,
                                             const float* __restrict__ ln_g, const float* __restrict__ ln_b, bf16_t* __restrict__ cv, const int wv) {
    int tid_; asm volatile("v_mbcnt_lo_u32_b32 %0, -1, 0\n\tv_mbcnt_hi_u32_b32 %0, -1, %0" : "=v"(tid_)); tid_ += wv * 64;
    const int tid = tid_, lane = tid & 63, wid = tid >> 6;
    const bool grp_ = (gridDim.x == 256); const int c0_ = grp_ ? (int)(blockIdx.x & 7) * 64 + (int)(blockIdx.x >> 3) : (int)blockIdx.x, cs_ = grp_ ? 32 : (int)gridDim.x, ce_ = grp_ ? ((int)(blockIdx.x & 7) + 1) * 64 : M / 32;
    for (int chunk = c0_; chunk < ce_; chunk += cs_) {
        const int t0 = chunk * 32, s0 = t0 % SEQ;
        {
            const int c16 = tid & 127, rb = tid >> 7;
            const bf16_t* up = u + (size_t)(t0 - 30 + rb) * D + c16 * 8;
#pragma unroll 1
            for (int kb = 0; kb < 16; kb += 8) {
                u32x4 tv[8];
#pragma unroll
                for (int k = 0; k < 8; ++k) {
                    const int r = rb + 4 * (kb + k);
                    tv[k] = (u32x4){0u, 0u, 0u, 0u};
                    if (r < 62 && s0 - 30 + r >= 0) tv[k] = *(const u32x4*)(up + (size_t)(4 * (kb + k)) * D);
                }
#pragma unroll
                for (int k = 0; k < 8; ++k) { const int r = rb + 4 * (kb + k); if (r < 62) *(LAS u32x4*)(lds + r * 2048 + c16 * 16) = tv[k]; }
            }
        }
        __syncthreads();
        const int c0 = 2 * tid;
        float w0[31], w1[31];
#pragma unroll
        for (int j = 0; j < 31; ++j) { const pg8::f32x2 wv = *(const pg8::f32x2*)(w_dw + j * D + c0); w0[j] = wv.x; w1[j] = wv.y; }
        float ya[32], yb[32];
#pragma unroll 1
        for (int ps = 0; ps < 2; ++ps) {
            float a0[16], a1[16];
            { const pg8::f32x2 bb = *(const pg8::f32x2*)(b_dw + c0);
#pragma unroll
              for (int t = 0; t < 16; ++t) { a0[t] = bb.x; a1[t] = bb.y; } }
            const LAS unsigned char* lp = lds + ps * 16 * 2048 + tid * 4;
#pragma unroll
            for (int r = 0; r < 46; ++r) {
                const unsigned xw = *(const LAS unsigned*)(lp + r * 2048);
                const float x0 = __uint_as_float(xw << 16), x1 = __uint_as_float(xw & 0xffff0000u);
#pragma unroll
                for (int t = 0; t < 16; ++t) { const int j = r - t; if (j >= 0 && j <= 30) { a0[t] += w0[j] * x0; a1[t] += w1[j] * x1; } }
                if ((r & 7) == 7) asm volatile("" ::: "memory");
            }
            if (ps == 0) {
#pragma unroll
                for (int t = 0; t < 16; ++t) { ya[t] = a0[t]; yb[t] = a1[t]; }
            } else {
#pragma unroll
                for (int t = 0; t < 16; ++t) { ya[16 + t] = a0[t]; yb[16 + t] = a1[t]; }
            }
        }
        __syncthreads();
#pragma unroll
        for (int t = 0; t < 32; ++t) *(LAS pg8::f32x2*)(lds + (t * D + c0) * 4) = (pg8::f32x2){ya[t], yb[t]};
        __syncthreads();
#pragma unroll
        for (int tt = 0; tt < 4; ++tt) {
            const int t = wid * 4 + tt;
            f32x4 v[4]; float s = 0.f;
#pragma unroll
            for (int i = 0; i < 4; ++i) { v[i] = *(const LAS f32x4*)(lds + (t * D + 4 * lane + 256 * i) * 4); s += (v[i][0] + v[i][1]) + (v[i][2] + v[i][3]); }
            const float mean = wave_sum(s, lane) * (1.0f / D); float q = 0.f;
#pragma unroll
            for (int i = 0; i < 4; ++i) { v[i] = v[i] - mean; q += (v[i][0] * v[i][0] + v[i][1] * v[i][1]) + (v[i][2] * v[i][2] + v[i][3] * v[i][3]); }
            const float rstd = 1.0f / sqrtf(wave_sum(q, lane) * (1.0f / D) + 1e-5f);
#pragma unroll
            for (int i = 0; i < 4; ++i) {
                const int c = 4 * lane + 256 * i; const f32x4 g = *(const f32x4*)(ln_g + c), b = *(const f32x4*)(ln_b + c);
                f32x4 y = v[i] * rstd * g + b;
#pragma unroll
                for (int k = 0; k < 4; ++k) y[k] = y[k] * sigmoid_f(y[k]);
                u32x2 w; w.x = cvt_pk_bf16(y[0], y[1]); w.y = cvt_pk_bf16(y[2], y[3]);
                *(u32x2*)(cv + (size_t)(t0 + t) * D + c) = w;
            }
        }
        __syncthreads();
    }
}

namespace att {
constexpr int KBUF = 8192, VBUF = 16384, STAGE = KBUF + VBUF, NSTG = 4, OFF_TAB = NSTG * STAGE, TAB_N = 320, OFF_Q = OFF_TAB + TAB_N * 4, QSTR = 144;
__device__ __forceinline__ int crow(int r, int hi) { return (r & 3) + 8 * (r >> 2) + 4 * hi; }
#define MFMA32(a, b, c) __builtin_amdgcn_mfma_f32_32x32x16_bf16((a), (b), (c), 0, 0, 0)
#define ATT_DMA(gp, ldsoff) __builtin_amdgcn_global_load_lds((const unsigned*)(gp), (LAS unsigned*)(lds + (ldsoff)), 16, 0, 0)

__device__ __forceinline__ void attn_unit(LAS unsigned char* lds, int b, int h, int qb, const bf16_t* __restrict__ Q, const bf16_t* __restrict__ Kg, const bf16_t* __restrict__ Vt, bf16_t* __restrict__ O,
                                          const float* __restrict__ rel_bias, const float* __restrict__ subln, float lam, float post, float* __restrict__ osc  , const int wv) {
    int tid_; asm volatile("v_mbcnt_lo_u32_b32 %0, -1, 0\n\tv_mbcnt_hi_u32_b32 %0, -1, %0" : "=v"(tid_)); tid_ += wv * 64;
    const int tid = tid_, lane = tid & 63, wid = __builtin_amdgcn_readfirstlane(tid >> 6), r32 = lane & 31, hi = lane >> 5;
    const int qw = qb * 256 + 32 * wid, myq = qw + r32;
    const size_t tok0 = (size_t)b * SEQ;
    LAS float* tab = (LAS float*)(lds + OFF_TAB);
    const int NT = 4 * (qb + 1);
    const int prow = lane >> 3, pslot = lane & 7;
    const int ksw = (r32 >> 1) & 7;
    unsigned kofs[4];
#pragma unroll
    for (int c = 0; c < 4; ++c) kofs[c] = (unsigned)(r32 * 128 + (((2 * c + hi) ^ ksw) << 4));
    const unsigned vofs = (unsigned)(r32 * 128 + ((hi ^ ksw) << 4));
    const unsigned qaddr = (unsigned)(size_t)(lds + OFF_Q + (32 * wid + r32) * QSTR + hi * 16);
#define ATT_VREAD8(dst, a0, a1) asm volatile("ds_read_b128 %0, %8\n\tds_read_b128 %1, %8 offset:4096\n\tds_read_b128 %2, %8 offset:8192\n\tds_read_b128 %3, %8 offset:12288\n\t" \
        "ds_read_b128 %4, %9\n\tds_read_b128 %5, %9 offset:4096\n\tds_read_b128 %6, %9 offset:8192\n\tds_read_b128 %7, %9 offset:12288" \
        : "=&v"(dst[0]), "=&v"(dst[1]), "=&v"(dst[2]), "=&v"(dst[3]), "=&v"(dst[4]), "=&v"(dst[5]), "=&v"(dst[6]), "=&v"(dst[7]) : "v"(a0), "v"(a1) : "memory")
#define ATT_VWAIT8(dst) asm volatile("s_waitcnt lgkmcnt(0)" : "+v"(dst[0]), "+v"(dst[1]), "+v"(dst[2]), "+v"(dst[3]), "+v"(dst[4]), "+v"(dst[5]), "+v"(dst[6]), "+v"(dst[7]) :: "memory")
#pragma unroll 1
    for (int map = 0; map < 2; ++map) {
        asm volatile("s_waitcnt lgkmcnt(0)\n\ts_barrier" ::: "memory");
        int koff = (8 * wid + prow) * 64 + 8 * (pslot ^ ((4 * wid + (prow >> 1)) & 7));
        int voff0 = (16 * wid + prow) * 64 + 8 * (pslot ^ (prow >> 1));
        int voff1 = (16 * wid + 8 + prow) * 64 + 8 * (pslot ^ (4 + (prow >> 1)));
        asm volatile("" : "+v"(koff), "+v"(voff0), "+v"(voff1));
        const bf16_t* kg = Kg + (size_t)(b * 16 + map * 8 + h) * SEQ * 64;
        const bf16_t* vg = Vt + (size_t)(b * 8 + h) * 32 * 128 * 64;
        const int kdst = wid * 1024, vdst = KBUF + wid * 2048;
#define ATT_ISSUE(t_, slot_) do { const int so_ = (slot_) * STAGE; \
            ATT_DMA(kg + (t_) * 64 * 64 + koff, so_ + kdst); ATT_DMA(vg + (t_) * 128 * 64 + voff0, so_ + vdst); ATT_DMA(vg + (t_) * 128 * 64 + voff1, so_ + vdst + 1024); } while (0)
        ATT_ISSUE(0, 0); ATT_ISSUE(1, 1);
        if (map == 0 && tid < TAB_N) { const int n = tid - 96; float tv = -INFINITY;
            if (n >= 0) { int bk = n; if (n >= 16) { bk = (n >= 128) ? 31 : 16 + (int)(logf((float)n * (1.0f / 16.0f)) / 2.0794415416798357f * 16.0f); bk = bk > 31 ? 31 : bk; } tv = rel_bias[bk * NHEAD + h] * LOG2E; }
            tab[tid] = tv; }
        {
            const bf16_t* qp = Q + ((size_t)(b * 16 + map * 8 + h) * SEQ + qb * 256) * 64;
#pragma unroll
            for (int i = 0; i < 4; ++i) { const int ch = tid + 512 * i, row = ch >> 3, c8 = ch & 7; *(LAS u32x4*)(lds + OFF_Q + row * QSTR + c8 * 16) = *(const u32x4*)(qp + row * 64 + c8 * 8); }
        }
        f32x16 o[4];
#pragma unroll
        for (int et = 0; et < 4; ++et)
#pragma unroll
            for (int r = 0; r < 16; ++r) o[et][r] = 0.f;
        float mref = 0.f, lrun = 0.f;
        int slot = 0;
#pragma unroll 1
        for (int t = 0; t < NT; ++t) {
            if ((t & 1) == 0) {
                asm volatile("s_waitcnt vmcnt(0) lgkmcnt(0)\n\ts_barrier" ::: "memory");
                if (t + 2 < NT) { const int s2 = slot ^ 2; ATT_ISSUE(t + 2, s2); ATT_ISSUE(t + 3, s2 + 1); }
            }
            const int key0 = t * 64;
            if (key0 <= qw + 31) {
                const float c31 = tab[96 + 127];
                const LAS unsigned char* kb = lds + slot * STAGE; const LAS unsigned char* vb = kb + KBUF;
                const bool nearT = (qw - (key0 + 63)) < 113;
                const float init = (nearT ? 0.f : c31) - mref;
                f32x16 s0, s1;
#pragma unroll
                for (int r = 0; r < 16; ++r) { s0[r] = init; s1[r] = init; }
                const unsigned vaddr = (unsigned)(size_t)vb + vofs, va_b = vaddr ^ 64u;
                bf16x8 vfa[8], vfb[8];
                {
                    bf16x8 qf[4], kf0[4], kf1[4];
                    const unsigned kba = (unsigned)(size_t)kb;
                    asm volatile("ds_read_b128 %0, %12\n\tds_read_b128 %1, %12 offset:32\n\tds_read_b128 %2, %12 offset:64\n\tds_read_b128 %3, %12 offset:96\n\t"
                                 "ds_read_b128 %4, %13\n\tds_read_b128 %5, %14\n\tds_read_b128 %6, %15\n\tds_read_b128 %7, %16\n\t"
                                 "ds_read_b128 %8, %13 offset:4096\n\tds_read_b128 %9, %14 offset:4096\n\tds_read_b128 %10, %15 offset:4096\n\tds_read_b128 %11, %16 offset:4096\n\t"
                                 "s_waitcnt lgkmcnt(0)"
                                 : "=&v"(qf[0]), "=&v"(qf[1]), "=&v"(qf[2]), "=&v"(qf[3]), "=&v"(kf0[0]), "=&v"(kf0[1]), "=&v"(kf0[2]), "=&v"(kf0[3]), "=&v"(kf1[0]), "=&v"(kf1[1]), "=&v"(kf1[2]), "=&v"(kf1[3])
                                 : "v"(qaddr), "v"(kba + kofs[0]), "v"(kba + kofs[1]), "v"(kba + kofs[2]), "v"(kba + kofs[3]) : "memory");
                    ATT_VREAD8(vfa, vaddr, vaddr ^ 32u);
                    __builtin_amdgcn_sched_barrier(0);
#pragma unroll
                    for (int c = 0; c < 4; ++c) { s0 = MFMA32(kf0[c], qf[c], s0); s1 = MFMA32(kf1[c], qf[c], s1); }
                }
                if (nearT) {
                    const LAS float* tp = tab + (myq - key0 + 96 - 4 * hi - 63);
#pragma unroll
                    for (int r = 0; r < 16; ++r) { s0[r] += tp[63 - (r & 3) - 8 * (r >> 2)]; s1[r] += tp[31 - (r & 3) - 8 * (r >> 2)]; }
                }
                float tm = fmaxf(s0[0], s1[0]);
#pragma unroll
                for (int r = 1; r < 16; ++r) tm = fmaxf(tm, fmaxf(s0[r], s1[r]));
                tm = swap32_max(tm);
                const bool first = (t == 0);
                if (first || __builtin_amdgcn_ballot_w64(tm > 8.0f) != 0ull) {
                    const float dl = first ? tm : fmaxf(tm, 0.f); const float alpha = first ? 1.0f : __builtin_amdgcn_exp2f(-dl); mref += dl;
                    lrun *= alpha;
#pragma unroll
                    for (int et = 0; et < 4; ++et)
#pragma unroll
                        for (int r = 0; r < 16; ++r) o[et][r] *= alpha;
#pragma unroll
                    for (int r = 0; r < 16; ++r) { s0[r] -= dl; s1[r] -= dl; }
                }
                float ps = 0.f;
#pragma unroll
                for (int r = 0; r < 16; ++r) { s0[r] = __builtin_amdgcn_exp2f(s0[r]); s1[r] = __builtin_amdgcn_exp2f(s1[r]); ps += s0[r] + s1[r]; }
                lrun += ps;
                u32x4 pw[4];
                pw[0].x = cvt_pk_bf16(s0[0], s0[1]);  pw[0].y = cvt_pk_bf16(s0[2], s0[3]);   pw[0].z = cvt_pk_bf16(s0[4], s0[5]);   pw[0].w = cvt_pk_bf16(s0[6], s0[7]);
                pw[1].x = cvt_pk_bf16(s0[8], s0[9]);  pw[1].y = cvt_pk_bf16(s0[10], s0[11]); pw[1].z = cvt_pk_bf16(s0[12], s0[13]); pw[1].w = cvt_pk_bf16(s0[14], s0[15]);
                pw[2].x = cvt_pk_bf16(s1[0], s1[1]);  pw[2].y = cvt_pk_bf16(s1[2], s1[3]);   pw[2].z = cvt_pk_bf16(s1[4], s1[5]);   pw[2].w = cvt_pk_bf16(s1[6], s1[7]);
                pw[3].x = cvt_pk_bf16(s1[8], s1[9]);  pw[3].y = cvt_pk_bf16(s1[10], s1[11]); pw[3].z = cvt_pk_bf16(s1[12], s1[13]); pw[3].w = cvt_pk_bf16(s1[14], s1[15]);
                ATT_VWAIT8(vfa);
                ATT_VREAD8(vfb, va_b, va_b ^ 32u);
                __builtin_amdgcn_sched_barrier(0);
#pragma unroll
                for (int et = 0; et < 4; ++et) o[et] = MFMA32(vfa[et], __builtin_bit_cast(bf16x8, pw[0]), o[et]);
#pragma unroll
                for (int et = 0; et < 4; ++et) o[et] = MFMA32(vfa[4 + et], __builtin_bit_cast(bf16x8, pw[1]), o[et]);
                ATT_VWAIT8(vfb);
                __builtin_amdgcn_sched_barrier(0);
#pragma unroll
                for (int et = 0; et < 4; ++et) o[et] = MFMA32(vfb[et], __builtin_bit_cast(bf16x8, pw[2]), o[et]);
#pragma unroll
                for (int et = 0; et < 4; ++et) o[et] = MFMA32(vfb[4 + et], __builtin_bit_cast(bf16x8, pw[3]), o[et]);
            }
            slot = (slot == 3) ? 0 : slot + 1;
        }
#undef ATT_ISSUE
        const float inv = 1.0f / swap32_add(lrun);
        if (map == 0) {
#pragma unroll
            for (int et = 0; et < 4; ++et)
#pragma unroll
                for (int rq = 0; rq < 4; ++rq) ((f32x4*)(osc + tid * 64))[et * 4 + rq] = (f32x4){o[et][4 * rq] * inv, o[et][4 * rq + 1] * inv, o[et][4 * rq + 2] * inv, o[et][4 * rq + 3] * inv};
        } else {
            const float li = lam * inv; float ss = 0.f;
#pragma unroll
            for (int et = 0; et < 4; ++et) {
#pragma unroll
                for (int rq = 0; rq < 4; ++rq) { const f32x4 p1 = ((const f32x4*)(osc + tid * 64))[et * 4 + rq];
#pragma unroll
                    for (int i = 0; i < 4; ++i) { const float v = p1[i] - li * o[et][4 * rq + i]; o[et][4 * rq + i] = v; ss += v * v; } }
                asm volatile("" ::: "memory");
            }
            ss = swap32_add(ss);
            const float rstd = post / sqrtf(ss * (1.0f / 128.0f) + 1e-6f);
            bf16_t* op = O + (tok0 + myq) * D + h * 128;
#pragma unroll
            for (int et = 0; et < 4; ++et) {
#pragma unroll
                for (int rq = 0; rq < 4; ++rq) {
                    const int e0 = 32 * et + 8 * rq + 4 * hi; const f32x4 g = *(const f32x4*)(subln + e0);
                    u32x2 w; w.x = cvt_pk_bf16(o[et][4 * rq] * rstd * g[0], o[et][4 * rq + 1] * rstd * g[1]); w.y = cvt_pk_bf16(o[et][4 * rq + 2] * rstd * g[2], o[et][4 * rq + 3] * rstd * g[3]);
                    *(u32x2*)(op + e0) = w;
                }
                asm volatile("" ::: "memory");
            }
        }
    }
}
#undef ATT_DMA
#undef ATT_VREAD8
#undef ATT_VWAIT8
#undef MFMA32
}

struct Args { const float* in[31]; float* out; unsigned char* ws; unsigned long long pad; };
enum { I_X = 0, I_P, I_F1N, I_F1WIN, I_F1WOUT, I_MIXN, I_F2N, I_F2WIN, I_F2WOUT, I_PLEN, I_PLEG, I_PLEP, I_CWIN, I_CBIN, I_CWDW, I_CBDW, I_CLNG, I_CLNB, I_CWOUT, I_CBOUT,
       I_KVN, I_WKV, I_WQ, I_LQ1, I_LK1, I_LQ2, I_LK2, I_SUBLN, I_WO, I_RELB, I_FINALN };

__global__ void __launch_bounds__(NTHREADS) fwd_megakernel(Args args) {
    extern __shared__ __attribute__((aligned(16))) unsigned char lds_raw[];
    cg::grid_group grid = cg::this_grid();
    LAS unsigned char* lds = (LAS unsigned char*)lds_raw;
    const int wave = __builtin_amdgcn_readfirstlane(threadIdx.x >> 6);
#define LANE_ID() ({ int l_; asm volatile("v_mbcnt_lo_u32_b32 %0, -1, 0\n\tv_mbcnt_hi_u32_b32 %0, -1, %0" : "=v"(l_)); l_; })
    const int G = gridDim.x, bid = blockIdx.x;
    const int gw = bid * NWAVES + wave, ngw = G * NWAVES;
    unsigned char* ws = args.ws;
    bf16_t* const HB = (bf16_t*)(ws + WS_HB); bf16_t* const U = (bf16_t*)(ws + WS_U); bf16_t* const PB = (bf16_t*)(ws + WS_PB);
    bf16_t* const BQ = (bf16_t*)(ws + WS_BQ); bf16_t* const BO = (bf16_t*)(ws + WS_BO); bf16_t* const KB = (bf16_t*)(ws + WS_KB); bf16_t* const VT = (bf16_t*)(ws + WS_VT);
    float* const SSQ = (float*)(ws + WS_SSQ);
    float* const out = args.out;
#define SSQV(v) (SSQ + (size_t)((v) & 1) * M * 16)

    volatile LAS unsigned* bst = (volatile LAS unsigned*)(lds + LDS_BYTES - 64);
    unsigned* const barw = (unsigned*)(ws + WS_BAR);
    {
        const int lane = LANE_ID(), tid = wave * 64 + lane; int goff = 0;
        if (tid == 0) { bst[0] = 0u; bst[1] = 0u; }
        if (bid == 0) for (int i = tid; i < XB_ALL_WORDS; i += NTHREADS) __hip_atomic_store(barw + i, 0u, __ATOMIC_RELAXED, __HIP_MEMORY_SCOPE_AGENT);
        for (int l = 0; l < 4; ++l) {
            unsigned char* wl = ws + WS_W + (size_t)l * W_LAYER;
            conv_weight(args.in[I_F1WIN] + (size_t)l * D * 2 * DFF, D, 2 * DFF, args.in[I_F1N] + l * D, DFF, (bf16_t*)(wl + WL_1IN), goff, gw, ngw, lane);
            conv_weight(args.in[I_F1WOUT] + (size_t)l * DFF * D, DFF, D, nullptr, 0, (bf16_t*)(wl + WL_1OUT), goff, gw, ngw, lane);
            conv_weight(args.in[I_F2WIN] + (size_t)l * D * 2 * DFF, D, 2 * DFF, args.in[I_F2N] + l * D, DFF, (bf16_t*)(wl + WL_2IN), goff, gw, ngw, lane);
            conv_weight(args.in[I_F2WOUT] + (size_t)l * DFF * D, DFF, D, nullptr, 0, (bf16_t*)(wl + WL_2OUT), goff, gw, ngw, lane);
            conv_weight(args.in[I_PLEG] + (size_t)l * D * D, D, D, args.in[I_PLEN] + l * D, 0, (bf16_t*)(wl + WL_G), goff, gw, ngw, lane);
            conv_weight(args.in[I_PLEP] + (size_t)l * PLE * D, PLE, D, nullptr, 0, (bf16_t*)(wl + WL_P), goff, gw, ngw, lane);
        }
        for (int j = 0; j < 2; ++j) {
            conv_weight(args.in[I_CWIN] + (size_t)j * D * 2 * D, D, 2 * D, args.in[I_MIXN] + j * D, D, (bf16_t*)(ws + WS_CIN + (size_t)j * 4 * MiB), goff, gw, ngw, lane);
            conv_weight(args.in[I_CWOUT] + (size_t)j * D * D, D, D, nullptr, 0, (bf16_t*)(ws + WS_COUT + (size_t)j * 2 * MiB), goff, gw, ngw, lane);
            conv_weight(args.in[I_WQ] + (size_t)j * D * D, D, D, args.in[I_MIXN] + (2 + j) * D, 0, (bf16_t*)(ws + WS_WQ + (size_t)j * 2 * MiB), goff, gw, ngw, lane);
            conv_weight(args.in[I_WO] + (size_t)j * D * D, D, D, nullptr, 0, (bf16_t*)(ws + WS_WO + (size_t)j * 2 * MiB), goff, gw, ngw, lane);
        }
        conv_weight(args.in[I_WKV], D, 2 * D, args.in[I_KVN], 0, (bf16_t*)(ws + WS_KV), goff, gw, ngw, lane);
        const float* x = args.in[I_X];
        for (int m = gw; m < M; m += ngw) {
            const f32x4* xr = (const f32x4*)(x + (size_t)m * D) + lane; float s = 0.f;
            u32x2* ob = (u32x2*)(HB + (size_t)m * D) + lane;
#pragma unroll
            for (int j = 0; j < 4; ++j) { const f32x4 v = xr[64 * j]; u32x2 w; w.x = cvt_pk_bf16(v[0], v[1]); w.y = cvt_pk_bf16(v[2], v[3]); ob[64 * j] = w;
                const float r0 = __uint_as_float(w.x << 16), r1 = __uint_as_float(w.x & 0xffff0000u), r2 = __uint_as_float(w.y << 16), r3 = __uint_as_float(w.y & 0xffff0000u); s += (r0 * r0 + r1 * r1) + (r2 * r2 + r3 * r3); }
            s = wave_sum(s, lane);
            if (lane < 16) SSQV(0)[(size_t)m * 16 + lane] = (lane == 0) ? s : 0.f;
        }
        const f32x4* p4 = (const f32x4*)args.in[I_P]; u32x2* pb2 = (u32x2*)PB;
        {
            const size_t NP = (size_t)4 * M * PLE / 4, S = (size_t)G * NTHREADS;
            for (size_t i0 = (size_t)bid * NTHREADS + tid; i0 < NP; i0 += 8 * S) {
                f32x4 pv[8];
#pragma unroll
                for (int k = 0; k < 8; ++k) { const size_t i = i0 + k * S; pv[k] = (i < NP) ? p4[i] : (f32x4){0.f, 0.f, 0.f, 0.f}; }
#pragma unroll
                for (int k = 0; k < 8; ++k) { const size_t i = i0 + k * S; if (i < NP) { u32x2 w; w.x = cvt_pk_bf16(pv[k][0], pv[k][1]); w.y = cvt_pk_bf16(pv[k][2], pv[k][3]); pb2[i] = w; } }
            }
        }
    }
    grid.sync();
    const int gid8 = bid & 7, gloc = bid >> 3;
    const bool leader = (wave == 0) && (LANE_ID() == 0);
    if (leader) (void)xb_add(&barw[XB_GCEN(xb_xcc_id(), gid8)], 1u);
    const XcdBarrier xb = xcd_barrier_post(barw, bst, leader);
    if (leader) bst[2] = group_mode(barw);
    __syncthreads();
    const bool grp = __builtin_amdgcn_readfirstlane((int)bst[2]) != 0;
#define GRID_BAR() do { if (grp) group_barrier(barw, gid8, (wave == 0) && (LANE_ID() == 0)); else xcd_barrier(xb, (wave == 0) && (LANE_ID() == 0)); } while (0)
#define PANEL_BAR() do { if (grp) panel_barrier(barw, gid8 * 8 + (gloc & 7), (wave == 0) && (LANE_ID() == 0)); else xcd_barrier(xb, (wave == 0) && (LANE_ID() == 0)); } while (0)

    int ver = 0;
    const bf16_t* hbcur = HB;
#pragma unroll 1
    for (int l = 0; l < 4; ++l) {
        unsigned char* wl = ws + WS_W + (size_t)l * W_LAYER;
#pragma unroll 1
        for (int half = 0; half < 2; ++half) {
            {
                pg8::Gemm g{hbcur, (const bf16_t*)(wl + (half ? WL_2IN : WL_1IN)), M, 2 * DFF, D}; pg8::StaticOrder S; S.init(M, 2 * DFF, G, bid);
                pg8::EpiGlu<0> E{U, DFF, SSQV(ver), nullptr, 0};
                pg8::gemm_phase<pg8::EpiGlu<0>, pg8::StaticOrder, true, true>(lds, g, S, E, wave);
            }
            if (l == 2 && half == 0) {
                { pg8::Gemm g{hbcur, (const bf16_t*)(ws + WS_KV), M, D, D}; pg8::StaticOrder S; S.init(M, D, G, bid);
                  pg8::EpiBf16Rs E{KB, D, SSQV(ver), 1.0f, 1};
                  pg8::gemm_phase<pg8::EpiBf16Rs, pg8::StaticOrder, true, true>(lds, g, S, E, wave); }
                { pg8::Gemm g{(const bf16_t*)(ws + WS_KV) + (size_t)D * D, hbcur, D, M, D}; pg8::StaticOrder S; S.init(D, M, G, bid);
                  pg8::EpiVt E{VT, 0, SSQV(ver)};
                  pg8::gemm_phase<pg8::EpiVt, pg8::StaticOrder, true, true>(lds, g, S, E, wave); }
            }
            PANEL_BAR();
            {
                pg8::Gemm g{U, (const bf16_t*)(wl + (half ? WL_2OUT : WL_1OUT)), M, D, DFF}; pg8::StaticOrder S; S.init(M, D, G, bid);
                pg8::EpiRes<0> E{hbcur, HB, SSQV(ver + 1), 0.5f, nullptr, nullptr, nullptr};
                pg8::gemm_phase<pg8::EpiRes<0>, pg8::StaticOrder, true, true, true>(lds, g, S, E, wave);
            }
            if (half == 1) {
                pg8::Gemm g{PB + (size_t)l * M * PLE, (const bf16_t*)(wl + WL_P), M, D, PLE}; pg8::StaticOrder S; S.init(M, D, G, bid);
                pg8::EpiBf16Rs E{BQ, D, nullptr, 1.0f, 0};
                pg8::gemm_phase<pg8::EpiBf16Rs, pg8::StaticOrder, true, true>(lds, g, S, E, wave);
            }
            PANEL_BAR();
            ++ver; hbcur = HB;
            if (half == 0) {
                if (l < 2) {
                    { pg8::Gemm g{HB, (const bf16_t*)(ws + WS_CIN + (size_t)l * 4 * MiB), M, 2 * D, D}; pg8::StaticOrder S; S.init(M, 2 * D, G, bid);
                      pg8::EpiGlu<1> E{BQ, D, SSQV(ver), args.in[I_CBIN] + l * 2 * D, D};
                      pg8::gemm_phase<pg8::EpiGlu<1>, pg8::StaticOrder, true, true>(lds, g, S, E, wave); }
                    GRID_BAR();
                    dwconv_phase(lds, BQ, args.in[I_CWDW] + l * 31 * D, args.in[I_CBDW] + l * D, args.in[I_CLNG] + l * D, args.in[I_CLNB] + l * D, BO, wave);
                    GRID_BAR();
                } else {
                    const int j = __builtin_amdgcn_readfirstlane(l - 2);
                    { pg8::Gemm g{HB, (const bf16_t*)(ws + WS_WQ + (size_t)j * 2 * MiB), M, D, D}; pg8::StaticOrder S; S.init(M, D, G, bid);
                      pg8::EpiBf16Rs E{BQ, D, SSQV(ver), QSCALE, 1};
                      pg8::gemm_phase<pg8::EpiBf16Rs, pg8::StaticOrder, true, true>(lds, g, S, E, wave); }
                    GRID_BAR();
                    {
                        int lane_ = LANE_ID(); asm volatile("" : "+v"(lane_));
                        const float a = args.in[I_LQ1][j * 64 + lane_] * args.in[I_LK1][j * 64 + lane_], b2 = args.in[I_LQ2][j * 64 + lane_] * args.in[I_LK2][j * 64 + lane_];
                        const float linit = (j == 0) ? 0.4707130183f : 0.5560582042f;
                        const float post = (j == 0) ? 0.5292869817f : 0.4439417958f;
                        const float lam = __uint_as_float(__builtin_amdgcn_readfirstlane(__float_as_uint(expf(wave_sum(a, lane_)) - expf(wave_sum(b2, lane_)) + linit)));
                        const int vbid = (G % 8 == 0) ? (bid % 8) * (G / 8) + bid / 8 : bid;
                        for (int pi = vbid; pi < 256; pi += G) {
                            const int bh = pi >> 2, s = pi & 3;
#pragma unroll 1
                            for (int uu = 0; uu < 2; ++uu)
                                att::attn_unit(lds, bh >> 3, bh & 7, uu ? s : 7 - s, BQ, KB, VT, BO, args.in[I_RELB], args.in[I_SUBLN] + j * 128, lam, post, grp ? (float*)((unsigned char*)U + (size_t)gid8 * 16 * MiB) + (size_t)gloc * 64 * 512 : (float*)U + (size_t)bid * 64 * 512, wave);
                        }
                    }
                    GRID_BAR();
                }
                {
                    const bf16_t* Bw = (l < 2) ? (const bf16_t*)(ws + WS_COUT + (size_t)l * 2 * MiB) : (const bf16_t*)(ws + WS_WO + (size_t)(l - 2) * 2 * MiB);
                    pg8::Gemm g{BO, Bw, M, D, D}; pg8::StaticOrder S; S.init(M, D, G, bid);
                    pg8::EpiRes<0> E{HB, HB, SSQV(ver + 1), 1.0f, (l < 2) ? args.in[I_CBOUT] + l * D : nullptr, nullptr, nullptr};
                    pg8::gemm_phase<pg8::EpiRes<0>, pg8::StaticOrder, true, true>(lds, g, S, E, wave);
                }
                PANEL_BAR();
                ++ver;
            }
        }
        {
            pg8::Gemm g{HB, (const bf16_t*)(wl + WL_G), M, D, D}; pg8::StaticOrder S; S.init(M, D, G, bid);
            pg8::EpiRes<1> E{HB, BO, SSQV(ver + 1), 1.0f, nullptr, SSQV(ver), BQ};
            pg8::gemm_phase<pg8::EpiRes<1>, pg8::StaticOrder, true, true>(lds, g, S, E, wave);
        }
        if (l == 1) GRID_BAR(); else PANEL_BAR();
        ++ver; hbcur = BO;
    }
    {
        const float* gn = args.in[I_FINALN]; int lane_ = LANE_ID(); asm volatile("" : "+v"(lane_));
        const int mstep = grp ? 1 : ngw;
        for (int m = grp ? (gid8 * 8 + (gloc & 7)) * 256 + (gloc >> 3) * 64 + wave * 8 : gw, mi = 0; m < M && (!grp || mi < 8); m += 2 * mstep, mi += 2) {
            const int m1 = m + mstep; const bool has1 = (m1 < M);
            u32x4 w[2][2];
#pragma unroll
            for (int rr = 0; rr < 2; ++rr) {
                const u32x4* hr = (const u32x4*)(hbcur + (size_t)((rr == 0 || has1) ? m + rr * mstep : m) * D) + lane_;
                w[rr][0] = hr[0]; w[rr][1] = hr[64];
            }
#pragma unroll
            for (int rr = 0; rr < 2; ++rr) {
                if (rr == 1 && !has1) break;
                const int mr = m + rr * mstep;
                float v[16]; float s = 0.f;
#pragma unroll
                for (int j = 0; j < 2; ++j) { const u32x4 ww = w[rr][j];
                    v[8 * j + 0] = __uint_as_float(ww.x << 16); v[8 * j + 1] = __uint_as_float(ww.x & 0xffff0000u); v[8 * j + 2] = __uint_as_float(ww.y << 16); v[8 * j + 3] = __uint_as_float(ww.y & 0xffff0000u);
                    v[8 * j + 4] = __uint_as_float(ww.z << 16); v[8 * j + 5] = __uint_as_float(ww.z & 0xffff0000u); v[8 * j + 6] = __uint_as_float(ww.w << 16); v[8 * j + 7] = __uint_as_float(ww.w & 0xffff0000u); }
#pragma unroll
                for (int i = 0; i < 16; ++i) s += v[i] * v[i];
                const float rstd = 1.0f / sqrtf(wave_sum(s, lane_) * (1.0f / D) + 1e-6f);
#pragma unroll
                for (int j = 0; j < 2; ++j) {
                    const int c = 8 * lane_ + 512 * j; const f32x4 g0 = *(const f32x4*)(gn + c), g1 = *(const f32x4*)(gn + c + 4);
                    f32x4* op = (f32x4*)(out + (size_t)mr * D + c);
                    op[0] = (f32x4){v[8 * j + 0] * rstd * g0[0], v[8 * j + 1] * rstd * g0[1], v[8 * j + 2] * rstd * g0[2], v[8 * j + 3] * rstd * g0[3]};
                    op[1] = (f32x4){v[8 * j + 4] * rstd * g1[0], v[8 * j + 5] * rstd * g1[1], v[8 * j + 6] * rstd * g1[2], v[8 * j + 7] * rstd * g1[3]};
                }
            }
        }
    }
}

extern "C" void kernel_launch(void* const* d_in, const int* in_sizes, int n_in, void* d_out, int out_size, void* d_ws, size_t ws_size, hipStream_t stream) {
    static int grid_blocks = 0;
    if (grid_blocks == 0) {
        if (n_in != 31 || out_size != M * D || ws_size < WS_END) { fprintf(stderr, "kernel_launch: unexpected shapes (n_in %d out %d ws %zu need %zu)\n", n_in, out_size, ws_size, (size_t)WS_END); grid_blocks = -1; return; }
        int dev = 0, cus = 0, per_cu = 0;
        hipGetDevice(&dev);
        hipDeviceGetAttribute(&cus, hipDeviceAttributeMultiprocessorCount, dev);
        hipFuncSetAttribute((const void*)fwd_megakernel, hipFuncAttributeMaxDynamicSharedMemorySize, LDS_BYTES);
        hipOccupancyMaxActiveBlocksPerMultiprocessor(&per_cu, (const void*)fwd_megakernel, NTHREADS, LDS_BYTES);
        if (per_cu < 1) per_cu = 1;
        if (per_cu > 1) per_cu = 1;
        grid_blocks = cus * per_cu;
        (void)hipGetLastError();
    }
    if (grid_blocks < 0) return;
    Args a{};
    for (int i = 0; i < 31; ++i) a.in[i] = (const float*)d_in[i];
    a.out = (float*)d_out; a.ws = (unsigned char*)d_ws; a.pad = 0ull;
    void* kargs[] = {&a};
    hipError_t e = hipLaunchCooperativeKernel((const void*)fwd_megakernel, dim3(grid_blocks), dim3(NTHREADS), kargs, LDS_BYTES, stream);
    if (e != hipSuccess) fprintf(stderr, "cooperative launch failed: %s (grid %d)\n", hipGetErrorString(e), grid_blocks);
}
```

```cpp
#include <hip/hip_runtime.h>
#include <hip/hip_cooperative_groups.h>
#include <cstdio>
#include <cstdint>
#include <cmath>
namespace cg = cooperative_groups;
namespace pg8 {
#define PG8_LAS __attribute__((address_space(3)))
typedef unsigned short bf16_t;
typedef short bf16x8 __attribute__((ext_vector_type(8)));
typedef float f32x4 __attribute__((ext_vector_type(4)));
typedef unsigned u32x4 __attribute__((ext_vector_type(4)));
constexpr int BM = 256, BK = 64, HALF = 128, HTB = HALF * BK * 2  , STAGE_BYTES = 8 * HTB, NXCD = 8, WGM = 8;

__host__ __device__ __forceinline__ int lds_byte(int r, int c) { const int st = (r >> 4) * 2 + (c >> 5), rr = r & 15, cc = c & 31, ob = rr * 64 + cc * 2; return st * 1024 + (ob ^ (((ob >> 9) & 1) << 5)); }
__host__ __device__ __forceinline__ void stage_rc(int b, int& R, int& C) { const int st = b / 1024, sb = b % 1024, swz = sb ^ (((sb >> 9) & 1) << 5); R = (st >> 1) * 16 + swz / 64; C = (st & 1) * 32 + (swz % 64) / 2; }
__host__ __device__ __forceinline__ int perm32(int rho) { const int n = rho >> 4, i = rho & 15; return 8 * (i >> 2) + 4 * n + (i & 3); }

struct Unit { int pm, pn; };
struct Gemm { const bf16_t* A; const bf16_t* Bt; int M, N, K; };

struct StaticOrder {
    int nM, nN, nwg, G, c;
    __host__ __device__ void init(int M, int N, int G_, int c_) { nM = M / BM; nN = N / BM; nwg = nM * nN; G = G_; c = c_; }
    __host__ __device__ bool next(int i, Unit& u) const {
        const long L = (long)i * G + c; if (L >= nwg) return false;
        int wgid = (int)L; { const int q = nwg / NXCD, r = nwg % NXCD, xcd = wgid % NXCD, off = wgid / NXCD; wgid = (xcd < r ? xcd * (q + 1) : r * (q + 1) + (xcd - r) * q) + off; }
        const int nig = WGM * nN, gid = wgid / nig, fm = gid * WGM, gsz = (nM - fm) < WGM ? (nM - fm) : WGM;
        u.pm = fm + ((wgid % nig) % gsz); u.pn = (wgid % nig) / gsz; return true;
    }
    __device__ __forceinline__ void a_ready(const Unit&) const {}
    __device__ __forceinline__ void done(const Unit&) const {}
};


typedef float f32x2 __attribute__((ext_vector_type(2)));
typedef unsigned u32x2 __attribute__((ext_vector_type(2)));
__device__ __forceinline__ unsigned cvt_pk_bf16(float lo, float hi) {
    typedef __bf16 bf16x2_t __attribute__((ext_vector_type(2)));
    f32x2 v = {lo, hi}; bf16x2_t b = __builtin_convertvector(v, bf16x2_t); return __builtin_bit_cast(unsigned, b);
}
__device__ __forceinline__ float sigmoid_f(float x) { return __builtin_amdgcn_rcpf(1.0f + __builtin_amdgcn_exp2f(-1.4426950408889634f * x)); }
__device__ __forceinline__ float row_rstd(const float* ssq, int row) {
    const f32x4* p = (const f32x4*)(ssq + (size_t)row * 16);
    const f32x4 a = p[0], b = p[1], c = p[2], d = p[3];
    const float s = (((a[0] + a[1]) + (a[2] + a[3])) + ((b[0] + b[1]) + (b[2] + b[3]))) + (((c[0] + c[1]) + (c[2] + c[3])) + ((d[0] + d[1]) + (d[2] + d[3])));
    return 1.0f / sqrtf(s * (1.0f / 1024.0f) + 1e-6f);
}

__device__ __forceinline__ float xor_lane(float v, int lane, int mask) { return __int_as_float(__builtin_amdgcn_ds_bpermute((lane ^ mask) << 2, __float_as_int(v))); }
__device__ __forceinline__ float row_rstd_d(const float* ssq, int row, int lane) {
    const f32x4 a = *(const f32x4*)(ssq + (size_t)row * 16 + 4 * (lane >> 4));
    float s = (a[0] + a[1]) + (a[2] + a[3]);
    s += xor_lane(s, lane, 16); s += xor_lane(s, lane, 32);
    return __builtin_amdgcn_rsqf(s * (1.0f / 1024.0f) + 1e-6f);
}

__device__ __forceinline__ void rows_rstd8(const float* ssq, int row0, int lane, float (&o)[8]) {
    f32x4 a[8];
#pragma unroll
    for (int g = 0; g < 8; ++g) a[g] = *(const f32x4*)(ssq + (size_t)(row0 + (g >> 2) * HALF + (g & 3) * 16) * 16 + 4 * (lane >> 4));
    asm volatile("" ::: "memory");
#pragma unroll
    for (int g = 0; g < 8; ++g) { float s = (a[g][0] + a[g][1]) + (a[g][2] + a[g][3]); s += xor_lane(s, lane, 16); s += xor_lane(s, lane, 32); o[g] = __builtin_amdgcn_rsqf(s * (1.0f / 1024.0f) + 1e-6f); }
}

template <int MODE> struct EpiGlu {
    static constexpr bool PERM = true, AFTER_DRAIN = false;
    bf16_t* O; int ldc; const float* ssq; const float* bias; int bias_half;
    __device__ __forceinline__ void row_pre(const Unit& u, int wr_, float (&o)[8]) const {
        int l_; asm volatile("v_mbcnt_lo_u32_b32 %0, -1, 0\n\tv_mbcnt_hi_u32_b32 %0, -1, %0" : "=v"(l_));
        const int row0 = u.pm * BM + __builtin_amdgcn_readfirstlane(wr_) * 64 + (l_ & 15);
        rows_rstd8(ssq, row0, l_, o);
    }
    __device__ __forceinline__ void operator()(const f32x4 (&acc)[2][2][4][2], const Unit& u, int wr_, int wc_, int fr_, int fq_, const float (&rpre)[8]) const {
        int l_; asm volatile("v_mbcnt_lo_u32_b32 %0, -1, 0\n\tv_mbcnt_hi_u32_b32 %0, -1, %0" : "=v"(l_));
        const int fr = l_ & 15, fq = l_ >> 4, wr = __builtin_amdgcn_readfirstlane(wr_), wc = __builtin_amdgcn_readfirstlane(wc_);
        const int row0 = u.pm * BM + wr * 64 + fr; const int j0 = u.pn * HALF + wc * 32 + 8 * fq;
        f32x4 b0[2], b1[2];
#pragma unroll
        for (int n = 0; n < 2; ++n) { b0[n] = bias ? *(const f32x4*)(bias + j0 + 4 * n) : (f32x4){0.f, 0.f, 0.f, 0.f}; b1[n] = bias ? *(const f32x4*)(bias + bias_half + j0 + 4 * n) : (f32x4){0.f, 0.f, 0.f, 0.f}; }
#pragma unroll
        for (int ai = 0; ai < 2; ++ai)
#pragma unroll
            for (int m = 0; m < 4; ++m) {
                const int row = row0 + ai * HALF + m * 16; const float rs = rpre[ai * 4 + m];
                float o[8];
                if (MODE == 0) {
                    const float nrl = rs * -1.4426950408889634f, rs2 = rs * rs;
#pragma unroll
                    for (int n = 0; n < 2; ++n)
#pragma unroll
                        for (int h2 = 0; h2 < 2; ++h2) {
                            const f32x2 g2 = {acc[ai][0][m][n][2 * h2], acc[ai][0][m][n][2 * h2 + 1]}, u2 = {acc[ai][1][m][n][2 * h2], acc[ai][1][m][n][2 * h2 + 1]};
                            const f32x2 a2 = g2 * nrl; f32x2 d2; d2.x = __builtin_amdgcn_exp2f(a2.x); d2.y = __builtin_amdgcn_exp2f(a2.y);
                            d2 = d2 + 1.0f; f32x2 r2; r2.x = __builtin_amdgcn_rcpf(d2.x); r2.y = __builtin_amdgcn_rcpf(d2.y);
                            const f32x2 o2 = (g2 * u2) * (r2 * rs2);
                            o[4 * n + 2 * h2] = o2.x; o[4 * n + 2 * h2 + 1] = o2.y;
                        }
                } else {
#pragma unroll
                for (int n = 0; n < 2; ++n) {
                    const f32x4 x = acc[ai][0][m][n] * rs + b0[n], y = acc[ai][1][m][n] * rs + b1[n];
#pragma unroll
                    for (int i = 0; i < 4; ++i) o[4 * n + i] = x[i] * sigmoid_f(y[i]);
                }
                }
                u32x4 w; w.x = cvt_pk_bf16(o[0], o[1]); w.y = cvt_pk_bf16(o[2], o[3]); w.z = cvt_pk_bf16(o[4], o[5]); w.w = cvt_pk_bf16(o[6], o[7]);
                if (MODE == 0) *(u32x4*)((char*)O + ((size_t)(row >> 4) * (ldc >> 5) + (u.pn * 4 + wc)) * 1024 + (row & 15) * 64 + fq * 16) = w;
                else *(u32x4*)(O + (size_t)row * ldc + j0) = w;
            }
    }
};

struct EpiBf16Rs {
    static constexpr bool PERM = true, AFTER_DRAIN = false;
    bf16_t* O; int ldc; const float* ssq; float scale; int headmajor;
    __device__ __forceinline__ void row_pre(const Unit&, int, float (&o)[8]) const {
#pragma unroll
        for (int i = 0; i < 8; ++i) o[i] = 0.f; }
    __device__ __forceinline__ void operator()(const f32x4 (&acc)[2][2][4][2], const Unit& u, int wr_, int wc_, int fr_, int fq_, const float (&rpre)[8]) const {
        int l_; asm volatile("v_mbcnt_lo_u32_b32 %0, -1, 0\n\tv_mbcnt_hi_u32_b32 %0, -1, %0" : "=v"(l_));
        const int fr = l_ & 15, fq = l_ >> 4, wr = __builtin_amdgcn_readfirstlane(wr_), wc = __builtin_amdgcn_readfirstlane(wc_);
        const int row0 = u.pm * BM + wr * 64 + fr; const int col0 = u.pn * BM + wc * 32 + 8 * fq;
        float rs8[8];
        if (ssq) rows_rstd8(ssq, row0, l_, rs8);
        else {
#pragma unroll
            for (int g = 0; g < 8; ++g) rs8[g] = 1.0f;
        }
#pragma unroll
        for (int ai = 0; ai < 2; ++ai)
#pragma unroll
            for (int m = 0; m < 4; ++m) {
                const int row = row0 + ai * HALF + m * 16; const float rs = rs8[ai * 4 + m] * scale;
#pragma unroll
                for (int bj = 0; bj < 2; ++bj) { const f32x4 v0 = acc[ai][bj][m][0] * rs, v1 = acc[ai][bj][m][1] * rs;
                    u32x4 w; w.x = cvt_pk_bf16(v0[0], v0[1]); w.y = cvt_pk_bf16(v0[2], v0[3]); w.z = cvt_pk_bf16(v1[0], v1[1]); w.w = cvt_pk_bf16(v1[2], v1[3]);
                    const int col = col0 + bj * HALF;
                    if (headmajor) *(u32x4*)(O + ((size_t)((row >> 11) * 16 + (col >> 6)) * 2048 + (row & 2047)) * 64 + (col & 63)) = w;
                    else *(u32x4*)(O + (size_t)row * ldc + col) = w; }
            }
    }
};

struct EpiVt {
    static constexpr bool PERM = true, AFTER_DRAIN = false;
    bf16_t* O; int ldc; const float* ssq;
    __device__ __forceinline__ void row_pre(const Unit&, int, float (&o)[8]) const {
#pragma unroll
        for (int i = 0; i < 8; ++i) o[i] = 0.f; }
    __device__ __forceinline__ void operator()(const f32x4 (&acc)[2][2][4][2], const Unit& u, int wr_, int wc_, int fr_, int fq_, const float (&rpre)[8]) const {
        int l_; asm volatile("v_mbcnt_lo_u32_b32 %0, -1, 0\n\tv_mbcnt_hi_u32_b32 %0, -1, %0" : "=v"(l_));
        const int fr = l_ & 15, fq = l_ >> 4, wr = __builtin_amdgcn_readfirstlane(wr_), wc = __builtin_amdgcn_readfirstlane(wc_);
        const int row0 = u.pm * BM + wr * 64 + fr; const int col0 = u.pn * BM + wc * 32 + 8 * fq;
#pragma unroll
        for (int bj = 0; bj < 2; ++bj) {
            float rs[8];
#pragma unroll
            for (int i = 0; i < 8; ++i) rs[i] = row_rstd(ssq, col0 + bj * HALF + i);
#pragma unroll
            for (int ai = 0; ai < 2; ++ai)
#pragma unroll
                for (int m = 0; m < 4; ++m) { const int row = row0 + ai * HALF + m * 16; const f32x4 v0 = acc[ai][bj][m][0], v1 = acc[ai][bj][m][1];
                    u32x2 wa, wb; wa.x = cvt_pk_bf16(v0[0] * rs[0], v0[1] * rs[1]); wa.y = cvt_pk_bf16(v0[2] * rs[2], v0[3] * rs[3]); wb.x = cvt_pk_bf16(v1[0] * rs[4], v1[1] * rs[5]); wb.y = cvt_pk_bf16(v1[2] * rs[6], v1[3] * rs[7]);
                    const int tp = col0 + bj * HALF - 4 * (fq & 1);
                    bf16_t* p = O + ((size_t)(((tp >> 11) * 8 + (row >> 7)) * 32 + ((tp & 2047) >> 6)) * 128 + (row & 127)) * 64 + (tp & 63);
                    *(u32x2*)p = wa; *(u32x2*)(p + 8) = wb; }
        }
    }
};

__device__ __forceinline__ void unpack8(const u32x4 w, float (&f)[8]) {
    f[0] = __uint_as_float(w.x << 16); f[1] = __uint_as_float(w.x & 0xffff0000u); f[2] = __uint_as_float(w.y << 16); f[3] = __uint_as_float(w.y & 0xffff0000u);
    f[4] = __uint_as_float(w.z << 16); f[5] = __uint_as_float(w.z & 0xffff0000u); f[6] = __uint_as_float(w.w << 16); f[7] = __uint_as_float(w.w & 0xffff0000u);
}
template <int MODE> struct EpiRes {
    static constexpr bool PERM = true, AFTER_DRAIN = false;
    const bf16_t* base; bf16_t* hb; float* ssq_out; float alpha; const float* bias; const float* ssq_in; const bf16_t* pp;
    __device__ __forceinline__ void row_pre(const Unit&, int, float (&o)[8]) const {
#pragma unroll
        for (int i = 0; i < 8; ++i) o[i] = 0.f; }
    __device__ __forceinline__ void operator()(const f32x4 (&acc)[2][2][4][2], const Unit& u, int wr, int wc, int fr_, int fq_, const float (&rpre)[8]) const {
        int l_; asm volatile("v_mbcnt_lo_u32_b32 %0, -1, 0\n\tv_mbcnt_hi_u32_b32 %0, -1, %0" : "=v"(l_));
        const int fr = l_ & 15, fq = l_ >> 4;
        const int row0 = u.pm * BM + wr * 64 + fr; const int col0 = u.pn * BM + wc * 32 + 8 * fq;
        float bv[2][8];
#pragma unroll
        for (int bj = 0; bj < 2; ++bj) {
            const f32x4 b0 = (MODE == 0 && bias) ? *(const f32x4*)(bias + col0 + bj * HALF) : (f32x4){0.f, 0.f, 0.f, 0.f}, b1 = (MODE == 0 && bias) ? *(const f32x4*)(bias + col0 + bj * HALF + 4) : (f32x4){0.f, 0.f, 0.f, 0.f};
#pragma unroll
            for (int i = 0; i < 4; ++i) { bv[bj][i] = b0[i]; bv[bj][4 + i] = b1[i]; }
        }
        constexpr int GB = (MODE == 0) ? 8 : 4;
#pragma unroll
        for (int g0 = 0; g0 < 8; g0 += GB) {
            u32x4 cb[GB][2], cpw[GB][2]; float rsv[GB];
#pragma unroll
            for (int gi = 0; gi < GB; ++gi) {
                const int g = g0 + gi; const int row = row0 + (g >> 2) * HALF + (g & 3) * 16; const size_t off = (size_t)row * 1024 + col0;
#pragma unroll
                for (int bj = 0; bj < 2; ++bj) { cb[gi][bj] = *(const u32x4*)(base + off + bj * HALF); if (MODE == 1) cpw[gi][bj] = *(const u32x4*)(pp + off + bj * HALF); }
                rsv[gi] = (MODE == 1) ? row_rstd_d(ssq_in, row, l_) : 0.f;
            }
            asm volatile("" ::: "memory");
#pragma unroll
            for (int gi = 0; gi < GB; ++gi) {
                const int g = g0 + gi; const int ai = g >> 2, m = g & 3;
                const int row = row0 + ai * HALF + m * 16; const size_t off = (size_t)row * 1024 + col0;
                const float rs = rsv[gi]; float sq = 0.f;
#pragma unroll
                for (int bj = 0; bj < 2; ++bj) {
                    float b[8], p[8], v[8], rr[8]; unpack8(cb[gi][bj], b); if (MODE == 1) unpack8(cpw[gi][bj], p);
#pragma unroll
                    for (int i = 0; i < 8; ++i) { const float a = acc[ai][bj][m][i >> 2][i & 3];
                        v[i] = (MODE == 0) ? b[i] + a * alpha + bv[bj][i] : b[i] + sigmoid_f(a * rs) * p[i]; }
                    u32x4 w; w.x = cvt_pk_bf16(v[0], v[1]); w.y = cvt_pk_bf16(v[2], v[3]); w.z = cvt_pk_bf16(v[4], v[5]); w.w = cvt_pk_bf16(v[6], v[7]);
                    *(u32x4*)(hb + off + bj * HALF) = w;
                    unpack8(w, rr);
#pragma unroll
                    for (int i = 0; i < 8; i += 2) sq += rr[i] * rr[i] + rr[i + 1] * rr[i + 1];
                }
                sq += xor_lane(sq, l_, 16); sq += xor_lane(sq, l_, 32);
                if (fq == 0) ssq_out[(size_t)row * 16 + u.pn * 4 + wc] = sq;
            }
        }
    }
};
template <class Epi, class Sched, bool ALIGN_EPI = false, bool SP2 = false, bool ABLK = false  >
__device__ __forceinline__ void gemm_phase(PG8_LAS unsigned char* lds, const Gemm g, const Sched& S, const Epi& E, const int wv  ) {
    int tid_; asm volatile("v_mbcnt_lo_u32_b32 %0, -1, 0\n\tv_mbcnt_hi_u32_b32 %0, -1, %0" : "=v"(tid_)); tid_ += wv * 64;
    const int tid = tid_, wid = __builtin_amdgcn_readfirstlane(tid >> 6), lane = tid & 63, wr = wid >> 2, wc = wid & 3, fr = lane & 15, fq = lane >> 4;
    const int K = g.K, nt = K / BK;
    unsigned voffA[2], voffB[2];
#pragma unroll
    for (int i = 0; i < 2; ++i) { int R, C; stage_rc(tid * 16 + i * 8192, R, C); const int Rb = Epi::PERM ? ((R & ~31) + perm32(R & 31)) : R;
        voffA[i] = ABLK ? (unsigned)(((R >> 4) * (K >> 5) + (C >> 5)) * 1024 + (R & 15) * 64 + (C & 31) * 2) : (unsigned)(R * K + C) * 2u; voffB[i] = (unsigned)(Rb * K + C) * 2u; }
    const size_t kstepA = ABLK ? (size_t)2048 : (size_t)(BK * 2);
    const size_t kstep = (size_t)(BK * 2);
    const size_t hstep = (size_t)HALF * K * 2;
    const size_t tstep = 2 * hstep;
    const unsigned ldsw = (unsigned)wid * 1024u;
    const int aoff = lds_byte(wr * 64 + fr, fq * 8), boff = lds_byte(wc * 32 + fr, fq * 8);
#define PG8_SA(b, h) (((b) * 2 + (h)) * HTB)
#define PG8_SB(b, h) ((4 + (b) * 2 + (h)) * HTB)
#define PG8_STAGE(bufoff, gbase, voff) do { _Pragma("unroll") for (int _i = 0; _i < 2; ++_i) \
        __builtin_amdgcn_global_load_lds((const unsigned*)((const char*)(gbase) + (voff)[_i]), (PG8_LAS unsigned*)(lds + (bufoff) + ldsw + _i * 8192), 16, 0, 0); } while (0)
#define PG8_LDA(dst, b, h) do { _Pragma("unroll") for (int m = 0; m < 4; ++m) _Pragma("unroll") for (int k = 0; k < 2; ++k) dst[m][k] = *(const PG8_LAS bf16x8*)(lds + PG8_SA(b, h) + aoff + m * 2048 + k * 1024); } while (0)
#define PG8_LDB(dst, b, h) do { _Pragma("unroll") for (int n = 0; n < 2; ++n) _Pragma("unroll") for (int k = 0; k < 2; ++k) dst[n][k] = *(const PG8_LAS bf16x8*)(lds + PG8_SB(b, h) + boff + n * 2048 + k * 1024); } while (0)
#define PG8_MMA(ai, bj, At, Bt) do { __builtin_amdgcn_s_setprio(1); _Pragma("unroll") for (int m = 0; m < 4; ++m) _Pragma("unroll") for (int n = 0; n < 2; ++n) _Pragma("unroll") for (int k = 0; k < 2; ++k) \
        acc[ai][bj][m][n] = __builtin_amdgcn_mfma_f32_16x16x32_bf16(Bt[n][k], At[m][k], acc[ai][bj][m][n], 0, 0, 0); __builtin_amdgcn_s_setprio(0); } while (0)
#define PG8_WAIT_V(n) asm volatile("s_waitcnt vmcnt(" #n ")" ::: "memory")
#define PG8_WAIT_L(n) asm volatile("s_waitcnt lgkmcnt(" #n ")" ::: "memory")
#define PG8_BAR __builtin_amdgcn_s_barrier()
#define PG8_SCHED __builtin_amdgcn_sched_barrier(0)
    Unit cur, nxt; int ui = 0;
    if (!S.next(0, cur)) return;
    f32x4 acc[2][2][4][2];
#pragma unroll
    for (int a = 0; a < 2; ++a)
#pragma unroll
        for (int b = 0; b < 2; ++b)
#pragma unroll
            for (int m = 0; m < 4; ++m)
#pragma unroll
                for (int n = 0; n < 2; ++n) acc[a][b][m][n] = (f32x4){0.f, 0.f, 0.f, 0.f};
    float rpre[8];
    bf16x8 At[4][2], B0[2][2], B1[2][2];
    const char* cA = (const char*)g.A + (size_t)cur.pm * tstep; const char* cB = (const char*)g.Bt + (size_t)cur.pn * tstep;
    S.a_ready(cur);
    if constexpr (SP2) {
        PG8_STAGE(PG8_SB(0, 0), cB, voffB); PG8_STAGE(PG8_SB(0, 1), cB + hstep, voffB); PG8_STAGE(PG8_SA(0, 0), cA, voffA); PG8_STAGE(PG8_SA(0, 1), cA + hstep, voffA);
        E.row_pre(cur, wr, rpre);
        if (wr == 1) PG8_BAR;
        PG8_WAIT_V(2); PG8_BAR;
        PG8_STAGE(PG8_SB(1, 0), cB + kstep, voffB); PG8_STAGE(PG8_SA(1, 0), cA + kstepA, voffA); PG8_STAGE(PG8_SB(1, 1), cB + hstep + kstep, voffB);
        PG8_WAIT_V(6); PG8_BAR;
    } else {
        PG8_STAGE(PG8_SB(0, 0), cB, voffB); PG8_STAGE(PG8_SA(0, 0), cA, voffA); PG8_STAGE(PG8_SB(0, 1), cB + hstep, voffB); PG8_STAGE(PG8_SA(0, 1), cA + hstep, voffA);
        E.row_pre(cur, wr, rpre);
        if (wr == 1) PG8_BAR;
        PG8_WAIT_V(4); PG8_BAR;
        PG8_STAGE(PG8_SB(1, 0), cB + kstep, voffB); PG8_STAGE(PG8_SA(1, 0), cA + kstepA, voffA); PG8_STAGE(PG8_SB(1, 1), cB + hstep + kstep, voffB);
        PG8_WAIT_V(6); PG8_BAR;
    }
    for (;;) {
        const bool has_next = S.next(ui + 1, nxt);
        const char* nA = has_next ? (const char*)g.A + (size_t)nxt.pm * tstep : cA; const char* nB = has_next ? (const char*)g.Bt + (size_t)nxt.pn * tstep : cB;
        for (int t = 0; t < nt; t += 2) {
            const bool last = (t == nt - 2);
            const char* a1 = cA + (size_t)(t + 1) * kstepA;
            const char* a2 = last ? nA : cA + (size_t)(t + 2) * kstepA; const char* b2 = last ? nB : cB + (size_t)(t + 2) * kstep;
            const char* a3 = a2 + kstepA; const char* b3 = b2 + kstep;
            if (last && has_next) S.a_ready(nxt);
            if constexpr (SP2) {
            PG8_LDB(B0, 0, 0); PG8_LDB(B1, 0, 1); PG8_SCHED; PG8_LDA(At, 0, 0); PG8_STAGE(PG8_SA(1, 1), a1 + hstep, voffA);
            PG8_WAIT_V(8); PG8_WAIT_L(0); PG8_BAR; PG8_MMA(0, 0, At, B0); PG8_MMA(0, 1, At, B1); PG8_BAR; PG8_SCHED;
            PG8_LDA(At, 0, 1); PG8_STAGE(PG8_SB(0, 0), b2, voffB); PG8_STAGE(PG8_SB(0, 1), b2 + hstep, voffB); PG8_STAGE(PG8_SA(0, 0), a2, voffA);
            PG8_WAIT_V(8); PG8_WAIT_L(0); PG8_BAR; PG8_MMA(1, 0, At, B0); PG8_MMA(1, 1, At, B1); PG8_BAR; PG8_SCHED;
            PG8_LDB(B0, 1, 0); PG8_LDB(B1, 1, 1); PG8_SCHED; PG8_LDA(At, 1, 0); PG8_STAGE(PG8_SA(0, 1), a2 + hstep, voffA);
            PG8_WAIT_V(8); PG8_WAIT_L(0); PG8_BAR; PG8_MMA(0, 0, At, B0); PG8_MMA(0, 1, At, B1); PG8_BAR; PG8_SCHED;
            PG8_LDA(At, 1, 1); PG8_STAGE(PG8_SB(1, 0), b3, voffB); PG8_STAGE(PG8_SB(1, 1), b3 + hstep, voffB); PG8_STAGE(PG8_SA(1, 0), a3, voffA);
            PG8_WAIT_V(8); PG8_WAIT_L(0); PG8_BAR; PG8_MMA(1, 0, At, B0); PG8_MMA(1, 1, At, B1); PG8_BAR; PG8_SCHED;
            } else {
            PG8_LDB(B0, 0, 0); PG8_SCHED; PG8_LDA(At, 0, 0); PG8_STAGE(PG8_SA(1, 1), a1 + hstep, voffA);
            PG8_WAIT_L(8); PG8_BAR; PG8_WAIT_L(0); PG8_MMA(0, 0, At, B0); PG8_BAR; PG8_SCHED;
            PG8_LDB(B1, 0, 1); PG8_STAGE(PG8_SB(0, 0), b2, voffB);
            PG8_BAR; PG8_WAIT_L(0); PG8_MMA(0, 1, At, B1); PG8_BAR;
            PG8_LDA(At, 0, 1); PG8_STAGE(PG8_SA(0, 0), a2, voffA);
            PG8_BAR; PG8_WAIT_L(0); PG8_MMA(1, 0, At, B0); PG8_BAR; PG8_SCHED;
            PG8_STAGE(PG8_SB(0, 1), b2 + hstep, voffB);
            PG8_WAIT_V(6); PG8_BAR; PG8_MMA(1, 1, At, B1); PG8_BAR;
            PG8_LDB(B0, 1, 0); PG8_SCHED; PG8_LDA(At, 1, 0); PG8_STAGE(PG8_SA(0, 1), a2 + hstep, voffA);
            PG8_WAIT_L(8); PG8_BAR; PG8_WAIT_L(0); PG8_MMA(0, 0, At, B0); PG8_BAR; PG8_SCHED;
            PG8_LDB(B1, 1, 1); PG8_STAGE(PG8_SB(1, 0), b3, voffB);
            PG8_BAR; PG8_WAIT_L(0); PG8_MMA(0, 1, At, B1); PG8_BAR;
            PG8_LDA(At, 1, 1); PG8_STAGE(PG8_SA(1, 0), a3, voffA);
            PG8_BAR; PG8_WAIT_L(0); PG8_MMA(1, 0, At, B0); PG8_BAR; PG8_SCHED;
            PG8_STAGE(PG8_SB(1, 1), b3 + hstep, voffB);
            PG8_WAIT_V(6); PG8_BAR; PG8_MMA(1, 1, At, B1); PG8_BAR;
            }
        }
        if constexpr (ALIGN_EPI) { if (wr == 0) PG8_BAR; }
        if constexpr (!Epi::AFTER_DRAIN) {
            float rnx[8];
            if (has_next) E.row_pre(nxt, wr, rnx);
            E(acc, cur, wr, wc, fr, fq, rpre); S.done(cur);
            if (has_next) {
#pragma unroll
                for (int i = 0; i < 8; ++i) rpre[i] = rnx[i];
            }
        }
        if (!has_next) break;
#pragma unroll
        for (int a = 0; a < 2; ++a)
#pragma unroll
            for (int b = 0; b < 2; ++b)
#pragma unroll
                for (int m = 0; m < 4; ++m)
#pragma unroll
                    for (int n = 0; n < 2; ++n) acc[a][b][m][n] = (f32x4){0.f, 0.f, 0.f, 0.f};
        cur = nxt; cA = nA; cB = nB; ++ui;
        if constexpr (ALIGN_EPI) { if (wr == 1) PG8_BAR; }
    }
    PG8_WAIT_V(0);
    if constexpr (!ALIGN_EPI) { if (wr == 0) PG8_BAR; }
    PG8_BAR;
    if constexpr (Epi::AFTER_DRAIN) { E.fused(acc, cur, wr, wc, fr, fq, lds, wid, lane); S.done(cur); }
#undef PG8_SA
#undef PG8_SB
#undef PG8_STAGE
#undef PG8_LDA
#undef PG8_LDB
#undef PG8_MMA
#undef PG8_WAIT_V
#undef PG8_WAIT_L
#undef PG8_BAR
#undef PG8_SCHED
}
}

#define LAS __attribute__((address_space(3)))
typedef pg8::bf16_t bf16_t;
typedef pg8::f32x4 f32x4;
typedef pg8::u32x4 u32x4;
typedef pg8::u32x2 u32x2;
typedef pg8::bf16x8 bf16x8;
typedef float f32x16 __attribute__((ext_vector_type(16)));
typedef short s16x4 __attribute__((ext_vector_type(4)));
using pg8::cvt_pk_bf16;
using pg8::sigmoid_f;

constexpr int NWAVES = 8, NTHREADS = 512;
constexpr int BATCH = 8, SEQ = 2048, D = 1024, DFF = 4096, M = BATCH * SEQ, PLE = 256, NHEAD = 8;
constexpr int LDS_BYTES = 139264;
constexpr float LOG2E = 1.4426950408889634f;
constexpr float QSCALE = 0.125f * LOG2E;

constexpr size_t MiB = 1u << 20;
constexpr size_t WS_W = 0;
constexpr size_t W_LAYER = 50 * MiB + 512 * 1024;
constexpr size_t WL_1IN = 0, WL_1OUT = 16 * MiB, WL_2IN = 24 * MiB, WL_2OUT = 40 * MiB, WL_G = 48 * MiB, WL_P = 50 * MiB;
constexpr size_t WS_CIN = 4 * W_LAYER;
constexpr size_t WS_COUT = WS_CIN + 8 * MiB;
constexpr size_t WS_KV = WS_COUT + 4 * MiB;
constexpr size_t WS_WQ = WS_KV + 4 * MiB;
constexpr size_t WS_WO = WS_WQ + 4 * MiB;
constexpr size_t WS_HB = WS_WO + 4 * MiB;
constexpr size_t WS_U = WS_HB + 32 * MiB;
constexpr size_t WS_PB = WS_U + 128 * MiB;
constexpr size_t WS_BQ = WS_PB + 32 * MiB;
constexpr size_t WS_BO = WS_BQ + 32 * MiB;
constexpr size_t WS_KB = WS_BO + 32 * MiB;
constexpr size_t WS_VT = WS_KB + 32 * MiB;
constexpr size_t WS_SSQ = WS_VT + 33 * MiB;
constexpr size_t WS_BAR = WS_SSQ + 2 * MiB;
constexpr size_t WS_END = WS_BAR + 64 * 1024;

#define XB_TMO      128
#define XB_XCNT(j)  (256  + 64 * (j))
#define XB_XSUB(j)  (1280 + 64 * (j))
#define XB_XGEN(j)  (2304 + 64 * (j))
#define XB_TOP      3328
#define XB_TOPGEN   3392
#define XCD_BAR_WORDS 3456
#define XB_SPIN_CAP (1u << 18)

__device__ __forceinline__ unsigned xb_ld(unsigned* p)              { return __hip_atomic_load(p, __ATOMIC_RELAXED, __HIP_MEMORY_SCOPE_AGENT); }
__device__ __forceinline__ unsigned xb_add(unsigned* p, unsigned v) { return __hip_atomic_fetch_add(p, v, __ATOMIC_RELAXED, __HIP_MEMORY_SCOPE_AGENT); }
__device__ __forceinline__ unsigned xb_xcc_id() { return (unsigned)__builtin_amdgcn_s_getreg((3 << 11) | 20) & 0xFu; }
#define XB_SPIN(cond, bar) do { unsigned _sp = 0; while (cond) { __builtin_amdgcn_s_sleep(1); \
    if ((++_sp & 255u) == 0u) { if (xb_ld(&(bar)[XB_TMO])) break; if (_sp > XB_SPIN_CAP) { atomicAdd(&(bar)[XB_TMO], 1u); break; } } } } while (0)

struct XcdBarrier {
    unsigned* bar; unsigned x;
    volatile LAS unsigned* st;
};

__device__ __forceinline__ XcdBarrier xcd_barrier_post(unsigned* bar, volatile LAS unsigned* st, const bool leader) {
    XcdBarrier b; b.bar = bar; b.x = xb_xcc_id(); b.st = st;
    if (leader) (void)xb_add(&bar[XB_XCNT(b.x)], 1u);
    return b;
}
__device__ __forceinline__ void xcd_barrier_complete(unsigned* bar, unsigned x, unsigned& nloc, unsigned& nx) {
    const unsigned G = gridDim.x * gridDim.y * gridDim.z;
    unsigned sum, cnt, mine, sp = 0u;
    for (;;) {
        sum = 0u; cnt = 0u; mine = 0u;
#pragma unroll
        for (unsigned j = 0; j < 16; ++j) { const unsigned c = xb_ld(&bar[XB_XCNT(j)]); sum += c; cnt += (c > 0u) ? 1u : 0u; mine = (j == x) ? c : mine; }
        if (sum == G) break;
        __builtin_amdgcn_s_sleep(1);
        if ((++sp & 255u) == 0u) { if (xb_ld(&bar[XB_TMO])) break; if (sp > XB_SPIN_CAP) { atomicAdd(&bar[XB_TMO], 1u); break; } }
    }
    nloc = mine > 0u ? mine : 1u; nx = cnt > 0u ? cnt : 1u;
}

__device__ __forceinline__ void xcd_barrier(const XcdBarrier& b, const bool leader) {
    asm volatile("s_waitcnt vmcnt(0)" ::: "memory");
    __syncthreads();
    if (leader) {
        unsigned* bar = b.bar;
        __builtin_amdgcn_s_waitcnt(0);
        unsigned nloc = b.st[0], nx = b.st[1];
        if (nloc == 0u) { xcd_barrier_complete(bar, b.x, nloc, nx); b.st[0] = nloc; b.st[1] = nx; }
        const unsigned old = xb_add(&bar[XB_XSUB(b.x)], 1u);
        const unsigned gen = old / nloc;
        if (old + 1u == (gen + 1u) * nloc) {
            __builtin_amdgcn_fence(__ATOMIC_RELEASE, "agent");
            asm volatile("s_waitcnt vmcnt(0)" ::: "memory");
            const unsigned og = xb_add(&bar[XB_TOP], 1u);
            const unsigned tg = og / nx;
            if (og + 1u == (tg + 1u) * nx) xb_add(&bar[XB_TOPGEN], 1u);
            else XB_SPIN(xb_ld(&bar[XB_TOPGEN]) == tg, bar);
            __builtin_amdgcn_fence(__ATOMIC_ACQUIRE, "agent");
            xb_add(&bar[XB_XGEN(b.x)], 1u);
            asm volatile("s_waitcnt vmcnt(0)" ::: "memory");
        } else {
            XB_SPIN(xb_ld(&bar[XB_XGEN(b.x)]) == gen, bar);
            __builtin_amdgcn_fence(__ATOMIC_ACQUIRE, "agent");
            asm volatile("s_waitcnt vmcnt(0)" ::: "memory");
        }
    }
    __syncthreads();
}

#define XB_GCNT(g)     (3584 + 64 * (g))
#define XB_GCEN(x, g)  (4096 + 64 * ((x) * 8 + (g)))
#define XB_GGEN(g)     (12288 + 64 * (g))
#define XB_PCNT(p)     (12800 + 16 * (p))
#define XB_PGEN(p)     (13824 + 16 * (p))
#define XB_ALL_WORDS   14848
__device__ __forceinline__ void group_barrier(unsigned* bar, const int g, const bool leader) {
    asm volatile("s_waitcnt vmcnt(0)" ::: "memory");
    __syncthreads();
    if (leader) {
        __builtin_amdgcn_s_waitcnt(0);
        const unsigned old = xb_add(&bar[XB_GCNT(g)], 1u); const unsigned gen = old / 32u;
        if (old + 1u == (gen + 1u) * 32u) xb_add(&bar[XB_GGEN(g)], 1u);
        else XB_SPIN(xb_ld(&bar[XB_GGEN(g)]) == gen, bar);
        __builtin_amdgcn_fence(__ATOMIC_ACQUIRE, "agent");
        asm volatile("s_waitcnt vmcnt(0)" ::: "memory");
    }
    __syncthreads();
}
__device__ __forceinline__ void panel_barrier(unsigned* bar, const int pidx, const bool leader) {
    asm volatile("s_waitcnt vmcnt(0)" ::: "memory");
    __syncthreads();
    if (leader) {
        __builtin_amdgcn_s_waitcnt(0);
        const unsigned old = xb_add(&bar[XB_PCNT(pidx)], 1u); const unsigned gen = old >> 2;
        if (old + 1u == (gen + 1u) * 4u) xb_add(&bar[XB_PGEN(pidx)], 1u);
        else XB_SPIN(xb_ld(&bar[XB_PGEN(pidx)]) == gen, bar);
        __builtin_amdgcn_fence(__ATOMIC_ACQUIRE, "agent");
        asm volatile("s_waitcnt vmcnt(0)" ::: "memory");
    }
    __syncthreads();
}
__device__ __forceinline__ unsigned group_mode(unsigned* bar) {
    if (gridDim.x != 256) return 0u;
    unsigned tot = 0u, sp = 0u;
    for (;;) {
        tot = 0u;
        for (unsigned i = 0; i < 128; ++i) tot += xb_ld(&bar[XB_GCEN(i >> 3, i & 7)]);
        if (tot == 256u) break;
        __builtin_amdgcn_s_sleep(1);
        if ((++sp & 255u) == 0u) { if (xb_ld(&bar[XB_TMO])) break; if (sp > XB_SPIN_CAP) { atomicAdd(&bar[XB_TMO], 1u); break; } }
    }
    if (tot != 256u) return 0u;
    unsigned fast = 1u;
    for (unsigned g = 0; g < 8; ++g) { unsigned mx = 0u; for (unsigned x = 0; x < 16; ++x) { const unsigned c = xb_ld(&bar[XB_GCEN(x, g)]); mx = c > mx ? c : mx; } if (mx != 32u) fast = 0u; }
    return fast;
}

__device__ __forceinline__ float wave_sum(float v, int lane) {
#pragma unroll
    for (int o = 1; o < 64; o <<= 1) v += pg8::xor_lane(v, lane, o);
    return v;
}
__device__ __forceinline__ float swap32_add(float x) { auto rr = __builtin_amdgcn_permlane32_swap(__float_as_uint(x), __float_as_uint(x), false, false); return __uint_as_float(rr[0]) + __uint_as_float(rr[1]); }
__device__ __forceinline__ float swap32_max(float x) { auto rr = __builtin_amdgcn_permlane32_swap(__float_as_uint(x), __float_as_uint(x), false, false); return fmaxf(__uint_as_float(rr[0]), __uint_as_float(rr[1])); }

__device__ __forceinline__ void conv_weight(const float* __restrict__ W, int K, int N, const float* __restrict__ gain, int glu_half, bf16_t* __restrict__ WT, int& goff, int gw, int ngw, int lane) {
    const int nnb = N / 128, items = nnb * (K / 64);
    int first = (gw - goff) % ngw; if (first < 0) first += ngw;
    goff = (goff + items) % ngw;
    for (int it = first; it < items; it += ngw) {
        const int nb = it % nnb, kb = it / nnb; const int n = nb * 128 + 2 * lane, k0 = kb * 64;
        pg8::f32x2 v[64];
#pragma unroll
        for (int i = 0; i < 64; ++i) v[i] = *(const pg8::f32x2*)(W + (size_t)(k0 + i) * N + n);
        if (gain) {
#pragma unroll
            for (int i = 0; i < 64; ++i) v[i] *= gain[k0 + i];
        }
        int dr = n;
        if (glu_half) { const int hf = n >= glu_half ? 1 : 0; const int j = n - hf * glu_half; dr = (j >> 7) * 256 + hf * 128 + (j & 127); }
#pragma unroll
        for (int c = 0; c < 2; ++c) {
            u32x4* dst = (u32x4*)(WT + (size_t)(dr + c) * K + k0);
#pragma unroll
            for (int q = 0; q < 8; ++q) { u32x4 w; w.x = cvt_pk_bf16(v[8 * q][c], v[8 * q + 1][c]); w.y = cvt_pk_bf16(v[8 * q + 2][c], v[8 * q + 3][c]); w.z = cvt_pk_bf16(v[8 * q + 4][c], v[8 * q + 5][c]); w.w = cvt_pk_bf16(v[8 * q + 6][c], v[8 * q + 7][c]); dst[q] = w; }
        }
    }
}

__device__ __forceinline__ void dwconv_phase(LAS unsigned char* lds, const bf16_t* __restrict__ u, const float* __restrict__ w_dw, const float* __restrict__ b_dw,
                                             const float* __restrict__ ln_g, const float* __restrict__ ln_b, bf16_t* __restrict__ cv, const int wv) {
    int tid_; asm volatile("v_mbcnt_lo_u32_b32 %0, -1, 0\n\tv_mbcnt_hi_u32_b32 %0, -1, %0" : "=v"(tid_)); tid_ += wv * 64;
    const int tid = tid_, lane = tid & 63, wid = tid >> 6;
    const bool grp_ = (gridDim.x == 256); const int c0_ = grp_ ? (int)(blockIdx.x & 7) * 64 + (int)(blockIdx.x >> 3) : (int)blockIdx.x, cs_ = grp_ ? 32 : (int)gridDim.x, ce_ = grp_ ? ((int)(blockIdx.x & 7) + 1) * 64 : M / 32;
    for (int chunk = c0_; chunk < ce_; chunk += cs_) {
        const int t0 = chunk * 32, s0 = t0 % SEQ;
        {
            const int c16 = tid & 127, rb = tid >> 7;
            const bf16_t* up = u + (size_t)(t0 - 30 + rb) * D + c16 * 8;
#pragma unroll 1
            for (int kb = 0; kb < 16; kb += 8) {
                u32x4 tv[8];
#pragma unroll
                for (int k = 0; k < 8; ++k) {
                    const int r = rb + 4 * (kb + k);
                    tv[k] = (u32x4){0u, 0u, 0u, 0u};
                    if (r < 62 && s0 - 30 + r >= 0) tv[k] = *(const u32x4*)(up + (size_t)(4 * (kb + k)) * D);
                }
#pragma unroll
                for (int k = 0; k < 8; ++k) { const int r = rb + 4 * (kb + k); if (r < 62) *(LAS u32x4*)(lds + r * 2048 + c16 * 16) = tv[k]; }
            }
        }
        __syncthreads();
        const int c0 = 2 * tid;
        float w0[31], w1[31];
#pragma unroll
        for (int j = 0; j < 31; ++j) { const pg8::f32x2 wv = *(const pg8::f32x2*)(w_dw + j * D + c0); w0[j] = wv.x; w1[j] = wv.y; }
        float ya[32], yb[32];
#pragma unroll 1
        for (int ps = 0; ps < 2; ++ps) {
            float a0[16], a1[16];
            { const pg8::f32x2 bb = *(const pg8::f32x2*)(b_dw + c0);
#pragma unroll
              for (int t = 0; t < 16; ++t) { a0[t] = bb.x; a1[t] = bb.y; } }
            const LAS unsigned char* lp = lds + ps * 16 * 2048 + tid * 4;
#pragma unroll
            for (int r = 0; r < 46; ++r) {
                const unsigned xw = *(const LAS unsigned*)(lp + r * 2048);
                const float x0 = __uint_as_float(xw << 16), x1 = __uint_as_float(xw & 0xffff0000u);
#pragma unroll
                for (int t = 0; t < 16; ++t) { const int j = r - t; if (j >= 0 && j <= 30) { a0[t] += w0[j] * x0; a1[t] += w1[j] * x1; } }
                if ((r & 7) == 7) asm volatile("" ::: "memory");
            }
            if (ps == 0) {
#pragma unroll
                for (int t = 0; t < 16; ++t) { ya[t] = a0[t]; yb[t] = a1[t]; }
            } else {
#pragma unroll
                for (int t = 0; t < 16; ++t) { ya[16 + t] = a0[t]; yb[16 + t] = a1[t]; }
            }
        }
        __syncthreads();
#pragma unroll
        for (int t = 0; t < 32; ++t) *(LAS pg8::f32x2*)(lds + (t * D + c0) * 4) = (pg8::f32x2){ya[t], yb[t]};
        __syncthreads();
#pragma unroll
        for (int tt = 0; tt < 4; ++tt) {
            const int t = wid * 4 + tt;
            f32x4 v[4]; float s = 0.f;
#pragma unroll
            for (int i = 0; i < 4; ++i) { v[i] = *(const LAS f32x4*)(lds + (t * D + 4 * lane + 256 * i) * 4); s += (v[i][0] + v[i][1]) + (v[i][2] + v[i][3]); }
            const float mean = wave_sum(s, lane) * (1.0f / D); float q = 0.f;
#pragma unroll
            for (int i = 0; i < 4; ++i) { v[i] = v[i] - mean; q += (v[i][0] * v[i][0] + v[i][1] * v[i][1]) + (v[i][2] * v[i][2] + v[i][3] * v[i][3]); }
            const float rstd = 1.0f / sqrtf(wave_sum(q, lane) * (1.0f / D) + 1e-5f);
#pragma unroll
            for (int i = 0; i < 4; ++i) {
                const int c = 4 * lane + 256 * i; const f32x4 g = *(const f32x4*)(ln_g + c), b = *(const f32x4*)(ln_b + c);
                f32x4 y = v[i] * rstd * g + b;
#pragma unroll
                for (int k = 0; k < 4; ++k) y[k] = y[k] * sigmoid_f(y[k]);
                u32x2 w; w.x = cvt_pk_bf16(y[0], y[1]); w.y = cvt_pk_bf16(y[2], y[3]);
                *(u32x2*)(cv + (size_t)(t0 + t) * D + c) = w;
            }
        }
        __syncthreads();
    }
}

namespace att {
constexpr int KBUF = 8192, VBUF = 16384, STAGE = KBUF + VBUF, NSTG = 4, OFF_TAB = NSTG * STAGE, TAB_N = 320, OFF_Q = OFF_TAB + TAB_N * 4, QSTR = 144;
__device__ __forceinline__ int crow(int r, int hi) { return (r & 3) + 8 * (r >> 2) + 4 * hi; }
#define MFMA32(a, b, c) __builtin_amdgcn_mfma_f32_32x32x16_bf16((a), (b), (c), 0, 0, 0)
#define ATT_DMA(gp, ldsoff) __builtin_amdgcn_global_load_lds((const unsigned*)(gp), (LAS unsigned*)(lds + (ldsoff)), 16, 0, 0)

__device__ __forceinline__ void attn_unit(LAS unsigned char* lds, int b, int h, int qb, const bf16_t* __restrict__ Q, const bf16_t* __restrict__ Kg, const bf16_t* __restrict__ Vt, bf16_t* __restrict__ O,
                                          const float* __restrict__ rel_bias, const float* __restrict__ subln, float lam, float post, float* __restrict__ osc  , const int wv) {
    int tid_; asm volatile("v_mbcnt_lo_u32_b32 %0, -1, 0\n\tv_mbcnt_hi_u32_b32 %0, -1, %0" : "=v"(tid_)); tid_ += wv * 64;
    const int tid = tid_, lane = tid & 63, wid = __builtin_amdgcn_readfirstlane(tid >> 6), r32 = lane & 31, hi = lane >> 5;
    const int qw = qb * 256 + 32 * wid, myq = qw + r32;
    const size_t tok0 = (size_t)b * SEQ;
    LAS float* tab = (LAS float*)(lds + OFF_TAB);
    const int NT = 4 * (qb + 1);
    const int prow = lane >> 3, pslot = lane & 7;
    const int ksw = (r32 >> 1) & 7;
    unsigned kofs[4];
#pragma unroll
    for (int c = 0; c < 4; ++c) kofs[c] = (unsigned)(r32 * 128 + (((2 * c + hi) ^ ksw) << 4));
    const unsigned vofs = (unsigned)(r32 * 128 + ((hi ^ ksw) << 4));
    const unsigned qaddr = (unsigned)(size_t)(lds + OFF_Q + (32 * wid + r32) * QSTR + hi * 16);
#define ATT_VREAD8(dst, a0, a1) asm volatile("ds_read_b128 %0, %8\n\tds_read_b128 %1, %8 offset:4096\n\tds_read_b128 %2, %8 offset:8192\n\tds_read_b128 %3, %8 offset:12288\n\t" \
        "ds_read_b128 %4, %9\n\tds_read_b128 %5, %9 offset:4096\n\tds_read_b128 %6, %9 offset:8192\n\tds_read_b128 %7, %9 offset:12288" \
        : "=&v"(dst[0]), "=&v"(dst[1]), "=&v"(dst[2]), "=&v"(dst[3]), "=&v"(dst[4]), "=&v"(dst[5]), "=&v"(dst[6]), "=&v"(dst[7]) : "v"(a0), "v"(a1) : "memory")
#define ATT_VWAIT8(dst) asm volatile("s_waitcnt lgkmcnt(0)" : "+v"(dst[0]), "+v"(dst[1]), "+v"(dst[2]), "+v"(dst[3]), "+v"(dst[4]), "+v"(dst[5]), "+v"(dst[6]), "+v"(dst[7]) :: "memory")
#pragma unroll 1
    for (int map = 0; map < 2; ++map) {
        asm volatile("s_waitcnt lgkmcnt(0)\n\ts_barrier" ::: "memory");
        int koff = (8 * wid + prow) * 64 + 8 * (pslot ^ ((4 * wid + (prow >> 1)) & 7));
        int voff0 = (16 * wid + prow) * 64 + 8 * (pslot ^ (prow >> 1));
        int voff1 = (16 * wid + 8 + prow) * 64 + 8 * (pslot ^ (4 + (prow >> 1)));
        asm volatile("" : "+v"(koff), "+v"(voff0), "+v"(voff1));
        const bf16_t* kg = Kg + (size_t)(b * 16 + map * 8 + h) * SEQ * 64;
        const bf16_t* vg = Vt + (size_t)(b * 8 + h) * 32 * 128 * 64;
        const int kdst = wid * 1024, vdst = KBUF + wid * 2048;
#define ATT_ISSUE(t_, slot_) do { const int so_ = (slot_) * STAGE; \
            ATT_DMA(kg + (t_) * 64 * 64 + koff, so_ + kdst); ATT_DMA(vg + (t_) * 128 * 64 + voff0, so_ + vdst); ATT_DMA(vg + (t_) * 128 * 64 + voff1, so_ + vdst + 1024); } while (0)
        ATT_ISSUE(0, 0); ATT_ISSUE(1, 1);
        if (map == 0 && tid < TAB_N) { const int n = tid - 96; float tv = -INFINITY;
            if (n >= 0) { int bk = n; if (n >= 16) { bk = (n >= 128) ? 31 : 16 + (int)(logf((float)n * (1.0f / 16.0f)) / 2.0794415416798357f * 16.0f); bk = bk > 31 ? 31 : bk; } tv = rel_bias[bk * NHEAD + h] * LOG2E; }
            tab[tid] = tv; }
        {
            const bf16_t* qp = Q + ((size_t)(b * 16 + map * 8 + h) * SEQ + qb * 256) * 64;
#pragma unroll
            for (int i = 0; i < 4; ++i) { const int ch = tid + 512 * i, row = ch >> 3, c8 = ch & 7; *(LAS u32x4*)(lds + OFF_Q + row * QSTR + c8 * 16) = *(const u32x4*)(qp + row * 64 + c8 * 8); }
        }
        f32x16 o[4];
#pragma unroll
        for (int et = 0; et < 4; ++et)
#pragma unroll
            for (int r = 0; r < 16; ++r) o[et][r] = 0.f;
        float mref = 0.f, lrun = 0.f;
        int slot = 0;
#pragma unroll 1
        for (int t = 0; t < NT; ++t) {
            if ((t & 1) == 0) {
                asm volatile("s_waitcnt vmcnt(0) lgkmcnt(0)\n\ts_barrier" ::: "memory");
                if (t + 2 < NT) { const int s2 = slot ^ 2; ATT_ISSUE(t + 2, s2); ATT_ISSUE(t + 3, s2 + 1); }
            }
            const int key0 = t * 64;
            if (key0 <= qw + 31) {
                const float c31 = tab[96 + 127];
                const LAS unsigned char* kb = lds + slot * STAGE; const LAS unsigned char* vb = kb + KBUF;
                const bool nearT = (qw - (key0 + 63)) < 113;
                const float init = (nearT ? 0.f : c31) - mref;
                f32x16 s0, s1;
#pragma unroll
                for (int r = 0; r < 16; ++r) { s0[r] = init; s1[r] = init; }
                const unsigned vaddr = (unsigned)(size_t)vb + vofs, va_b = vaddr ^ 64u;
                bf16x8 vfa[8], vfb[8];
                {
                    bf16x8 qf[4], kf0[4], kf1[4];
                    const unsigned kba = (unsigned)(size_t)kb;
                    asm volatile("ds_read_b128 %0, %12\n\tds_read_b128 %1, %12 offset:32\n\tds_read_b128 %2, %12 offset:64\n\tds_read_b128 %3, %12 offset:96\n\t"
                                 "ds_read_b128 %4, %13\n\tds_read_b128 %5, %14\n\tds_read_b128 %6, %15\n\tds_read_b128 %7, %16\n\t"
                                 "ds_read_b128 %8, %13 offset:4096\n\tds_read_b128 %9, %14 offset:4096\n\tds_read_b128 %10, %15 offset:4096\n\tds_read_b128 %11, %16 offset:4096\n\t"
                                 "s_waitcnt lgkmcnt(0)"
                                 : "=&v"(qf[0]), "=&v"(qf[1]), "=&v"(qf[2]), "=&v"(qf[3]), "=&v"(kf0[0]), "=&v"(kf0[1]), "=&v"(kf0[2]), "=&v"(kf0[3]), "=&v"(kf1[0]), "=&v"(kf1[1]), "=&v"(kf1[2]), "=&v"(kf1[3])
                                 : "v"(qaddr), "v"(kba + kofs[0]), "v"(kba + kofs[1]), "v"(kba + kofs[2]), "v"(kba + kofs[3]) : "memory");
                    ATT_VREAD8(vfa, vaddr, vaddr ^ 32u);
                    __builtin_amdgcn_sched_barrier(0);
#pragma unroll
                    for (int c = 0; c < 4; ++c) { s0 = MFMA32(kf0[c], qf[c], s0); s1 = MFMA32(kf1[c], qf[c], s1); }
                }
                if (nearT) {
                    const LAS float* tp = tab + (myq - key0 + 96 - 4 * hi - 63);
#pragma unroll
                    for (int r = 0; r < 16; ++r) { s0[r] += tp[63 - (r & 3) - 8 * (r >> 2)]; s1[r] += tp[31 - (r & 3) - 8 * (r >> 2)]; }
                }
                float tm = fmaxf(s0[0], s1[0]);
#pragma unroll
                for (int r = 1; r < 16; ++r) tm = fmaxf(tm, fmaxf(s0[r], s1[r]));
                const bool first = (t == 0);
                if (first || __builtin_amdgcn_ballot_w64(tm > 8.0f) != 0ull) {
                    tm = swap32_max(tm);
                    const float dl = first ? tm : fmaxf(tm, 0.f); const float alpha = first ? 1.0f : __builtin_amdgcn_exp2f(-dl); mref += dl;
                    lrun *= alpha;
#pragma unroll
                    for (int et = 0; et < 4; ++et)
#pragma unroll
                        for (int r = 0; r < 16; ++r) o[et][r] *= alpha;
#pragma unroll
                    for (int r = 0; r < 16; ++r) { s0[r] -= dl; s1[r] -= dl; }
                }
                float ps = 0.f;
#pragma unroll
                for (int r = 0; r < 16; ++r) { s0[r] = __builtin_amdgcn_exp2f(s0[r]); s1[r] = __builtin_amdgcn_exp2f(s1[r]); ps += s0[r] + s1[r]; }
                lrun += ps;
                u32x4 pw[4];
                pw[0].x = cvt_pk_bf16(s0[0], s0[1]);  pw[0].y = cvt_pk_bf16(s0[2], s0[3]);   pw[0].z = cvt_pk_bf16(s0[4], s0[5]);   pw[0].w = cvt_pk_bf16(s0[6], s0[7]);
                pw[1].x = cvt_pk_bf16(s0[8], s0[9]);  pw[1].y = cvt_pk_bf16(s0[10], s0[11]); pw[1].z = cvt_pk_bf16(s0[12], s0[13]); pw[1].w = cvt_pk_bf16(s0[14], s0[15]);
                pw[2].x = cvt_pk_bf16(s1[0], s1[1]);  pw[2].y = cvt_pk_bf16(s1[2], s1[3]);   pw[2].z = cvt_pk_bf16(s1[4], s1[5]);   pw[2].w = cvt_pk_bf16(s1[6], s1[7]);
                pw[3].x = cvt_pk_bf16(s1[8], s1[9]);  pw[3].y = cvt_pk_bf16(s1[10], s1[11]); pw[3].z = cvt_pk_bf16(s1[12], s1[13]); pw[3].w = cvt_pk_bf16(s1[14], s1[15]);
                ATT_VWAIT8(vfa);
                ATT_VREAD8(vfb, va_b, va_b ^ 32u);
                __builtin_amdgcn_sched_barrier(0);
#pragma unroll
                for (int et = 0; et < 4; ++et) o[et] = MFMA32(vfa[et], __builtin_bit_cast(bf16x8, pw[0]), o[et]);
#pragma unroll
                for (int et = 0; et < 4; ++et) o[et] = MFMA32(vfa[4 + et], __builtin_bit_cast(bf16x8, pw[1]), o[et]);
                ATT_VWAIT8(vfb);
                __builtin_amdgcn_sched_barrier(0);
#pragma unroll
                for (int et = 0; et < 4; ++et) o[et] = MFMA32(vfb[et], __builtin_bit_cast(bf16x8, pw[2]), o[et]);
#pragma unroll
                for (int et = 0; et < 4; ++et) o[et] = MFMA32(vfb[4 + et], __builtin_bit_cast(bf16x8, pw[3]), o[et]);
            }
            slot = (slot == 3) ? 0 : slot + 1;
        }
#undef ATT_ISSUE
        const float inv = 1.0f / swap32_add(lrun);
        if (map == 0) {
#pragma unroll
            for (int et = 0; et < 4; ++et)
#pragma unroll
                for (int rq = 0; rq < 4; ++rq) ((f32x4*)(osc + tid * 64))[et * 4 + rq] = (f32x4){o[et][4 * rq] * inv, o[et][4 * rq + 1] * inv, o[et][4 * rq + 2] * inv, o[et][4 * rq + 3] * inv};
        } else {
            const float li = lam * inv; float ss = 0.f;
#pragma unroll
            for (int et = 0; et < 4; ++et) {
#pragma unroll
                for (int rq = 0; rq < 4; ++rq) { const f32x4 p1 = ((const f32x4*)(osc + tid * 64))[et * 4 + rq];
#pragma unroll
                    for (int i = 0; i < 4; ++i) { const float v = p1[i] - li * o[et][4 * rq + i]; o[et][4 * rq + i] = v; ss += v * v; } }
                asm volatile("" ::: "memory");
            }
            ss = swap32_add(ss);
            const float rstd = post / sqrtf(ss * (1.0f / 128.0f) + 1e-6f);
            bf16_t* op = O + (tok0 + myq) * D + h * 128;
#pragma unroll
            for (int et = 0; et < 4; ++et) {
#pragma unroll
                for (int rq = 0; rq < 4; ++rq) {
                    const int e0 = 32 * et + 8 * rq + 4 * hi; const f32x4 g = *(const f32x4*)(subln + e0);
                    u32x2 w; w.x = cvt_pk_bf16(o[et][4 * rq] * rstd * g[0], o[et][4 * rq + 1] * rstd * g[1]); w.y = cvt_pk_bf16(o[et][4 * rq + 2] * rstd * g[2], o[et][4 * rq + 3] * rstd * g[3]);
                    *(u32x2*)(op + e0) = w;
                }
                asm volatile("" ::: "memory");
            }
        }
    }
}
#undef ATT_DMA
#undef ATT_VREAD8
#undef ATT_VWAIT8
#undef MFMA32
}

struct Args { const float* in[31]; float* out; unsigned char* ws; unsigned long long pad; };
enum { I_X = 0, I_P, I_F1N, I_F1WIN, I_F1WOUT, I_MIXN, I_F2N, I_F2WIN, I_F2WOUT, I_PLEN, I_PLEG, I_PLEP, I_CWIN, I_CBIN, I_CWDW, I_CBDW, I_CLNG, I_CLNB, I_CWOUT, I_CBOUT,
       I_KVN, I_WKV, I_WQ, I_LQ1, I_LK1, I_LQ2, I_LK2, I_SUBLN, I_WO, I_RELB, I_FINALN };

__global__ void __launch_bounds__(NTHREADS) fwd_megakernel(Args args) {
    extern __shared__ __attribute__((aligned(16))) unsigned char lds_raw[];
    cg::grid_group grid = cg::this_grid();
    LAS unsigned char* lds = (LAS unsigned char*)lds_raw;
    const int wave = __builtin_amdgcn_readfirstlane(threadIdx.x >> 6);
#define LANE_ID() ({ int l_; asm volatile("v_mbcnt_lo_u32_b32 %0, -1, 0\n\tv_mbcnt_hi_u32_b32 %0, -1, %0" : "=v"(l_)); l_; })
    const int G = gridDim.x, bid = blockIdx.x;
    const int gw = bid * NWAVES + wave, ngw = G * NWAVES;
    unsigned char* ws = args.ws;
    bf16_t* const HB = (bf16_t*)(ws + WS_HB); bf16_t* const U = (bf16_t*)(ws + WS_U); bf16_t* const PB = (bf16_t*)(ws + WS_PB);
    bf16_t* const BQ = (bf16_t*)(ws + WS_BQ); bf16_t* const BO = (bf16_t*)(ws + WS_BO); bf16_t* const KB = (bf16_t*)(ws + WS_KB); bf16_t* const VT = (bf16_t*)(ws + WS_VT);
    float* const SSQ = (float*)(ws + WS_SSQ);
    float* const out = args.out;
#define SSQV(v) (SSQ + (size_t)((v) & 1) * M * 16)

    volatile LAS unsigned* bst = (volatile LAS unsigned*)(lds + LDS_BYTES - 64);
    unsigned* const barw = (unsigned*)(ws + WS_BAR);
    {
        const int lane = LANE_ID(), tid = wave * 64 + lane; int goff = 0;
        if (tid == 0) { bst[0] = 0u; bst[1] = 0u; }
        if (bid == 0) for (int i = tid; i < XB_ALL_WORDS; i += NTHREADS) __hip_atomic_store(barw + i, 0u, __ATOMIC_RELAXED, __HIP_MEMORY_SCOPE_AGENT);
        for (int l = 0; l < 4; ++l) {
            unsigned char* wl = ws + WS_W + (size_t)l * W_LAYER;
            conv_weight(args.in[I_F1WIN] + (size_t)l * D * 2 * DFF, D, 2 * DFF, args.in[I_F1N] + l * D, DFF, (bf16_t*)(wl + WL_1IN), goff, gw, ngw, lane);
            conv_weight(args.in[I_F1WOUT] + (size_t)l * DFF * D, DFF, D, nullptr, 0, (bf16_t*)(wl + WL_1OUT), goff, gw, ngw, lane);
            conv_weight(args.in[I_F2WIN] + (size_t)l * D * 2 * DFF, D, 2 * DFF, args.in[I_F2N] + l * D, DFF, (bf16_t*)(wl + WL_2IN), goff, gw, ngw, lane);
            conv_weight(args.in[I_F2WOUT] + (size_t)l * DFF * D, DFF, D, nullptr, 0, (bf16_t*)(wl + WL_2OUT), goff, gw, ngw, lane);
            conv_weight(args.in[I_PLEG] + (size_t)l * D * D, D, D, args.in[I_PLEN] + l * D, 0, (bf16_t*)(wl + WL_G), goff, gw, ngw, lane);
            conv_weight(args.in[I_PLEP] + (size_t)l * PLE * D, PLE, D, nullptr, 0, (bf16_t*)(wl + WL_P), goff, gw, ngw, lane);
        }
        for (int j = 0; j < 2; ++j) {
            conv_weight(args.in[I_CWIN] + (size_t)j * D * 2 * D, D, 2 * D, args.in[I_MIXN] + j * D, D, (bf16_t*)(ws + WS_CIN + (size_t)j * 4 * MiB), goff, gw, ngw, lane);
            conv_weight(args.in[I_CWOUT] + (size_t)j * D * D, D, D, nullptr, 0, (bf16_t*)(ws + WS_COUT + (size_t)j * 2 * MiB), goff, gw, ngw, lane);
            conv_weight(args.in[I_WQ] + (size_t)j * D * D, D, D, args.in[I_MIXN] + (2 + j) * D, 0, (bf16_t*)(ws + WS_WQ + (size_t)j * 2 * MiB), goff, gw, ngw, lane);
            conv_weight(args.in[I_WO] + (size_t)j * D * D, D, D, nullptr, 0, (bf16_t*)(ws + WS_WO + (size_t)j * 2 * MiB), goff, gw, ngw, lane);
        }
        conv_weight(args.in[I_WKV], D, 2 * D, args.in[I_KVN], 0, (bf16_t*)(ws + WS_KV), goff, gw, ngw, lane);
        const float* x = args.in[I_X];
        for (int m = gw; m < M; m += ngw) {
            const f32x4* xr = (const f32x4*)(x + (size_t)m * D) + lane; float s = 0.f;
            u32x2* ob = (u32x2*)(HB + (size_t)m * D) + lane;
#pragma unroll
            for (int j = 0; j < 4; ++j) { const f32x4 v = xr[64 * j]; u32x2 w; w.x = cvt_pk_bf16(v[0], v[1]); w.y = cvt_pk_bf16(v[2], v[3]); ob[64 * j] = w;
                const float r0 = __uint_as_float(w.x << 16), r1 = __uint_as_float(w.x & 0xffff0000u), r2 = __uint_as_float(w.y << 16), r3 = __uint_as_float(w.y & 0xffff0000u); s += (r0 * r0 + r1 * r1) + (r2 * r2 + r3 * r3); }
            s = wave_sum(s, lane);
            if (lane < 16) SSQV(0)[(size_t)m * 16 + lane] = (lane == 0) ? s : 0.f;
        }
        const f32x4* p4 = (const f32x4*)args.in[I_P]; u32x2* pb2 = (u32x2*)PB;
        for (size_t i = (size_t)bid * NTHREADS + tid; i < (size_t)4 * M * PLE / 4; i += (size_t)G * NTHREADS) { const f32x4 v = p4[i]; u32x2 w; w.x = cvt_pk_bf16(v[0], v[1]); w.y = cvt_pk_bf16(v[2], v[3]); pb2[i] = w; }
    }
    grid.sync();
    const int gid8 = bid & 7, gloc = bid >> 3;
    const bool leader = (wave == 0) && (LANE_ID() == 0);
    if (leader) (void)xb_add(&barw[XB_GCEN(xb_xcc_id(), gid8)], 1u);
    const XcdBarrier xb = xcd_barrier_post(barw, bst, leader);
    if (leader) bst[2] = group_mode(barw);
    __syncthreads();
    const bool grp = __builtin_amdgcn_readfirstlane((int)bst[2]) != 0;
#define GRID_BAR() do { if (grp) group_barrier(barw, gid8, (wave == 0) && (LANE_ID() == 0)); else xcd_barrier(xb, (wave == 0) && (LANE_ID() == 0)); } while (0)
#define PANEL_BAR() do { if (grp) panel_barrier(barw, gid8 * 8 + (gloc & 7), (wave == 0) && (LANE_ID() == 0)); else xcd_barrier(xb, (wave == 0) && (LANE_ID() == 0)); } while (0)

    int ver = 0;
    const bf16_t* hbcur = HB;
#pragma unroll 1
    for (int l = 0; l < 4; ++l) {
        unsigned char* wl = ws + WS_W + (size_t)l * W_LAYER;
#pragma unroll 1
        for (int half = 0; half < 2; ++half) {
            {
                pg8::Gemm g{hbcur, (const bf16_t*)(wl + (half ? WL_2IN : WL_1IN)), M, 2 * DFF, D}; pg8::StaticOrder S; S.init(M, 2 * DFF, G, bid);
                pg8::EpiGlu<0> E{U, DFF, SSQV(ver), nullptr, 0};
                pg8::gemm_phase<pg8::EpiGlu<0>, pg8::StaticOrder, true, true>(lds, g, S, E, wave);
            }
            if (l == 2 && half == 0) {
                { pg8::Gemm g{hbcur, (const bf16_t*)(ws + WS_KV), M, D, D}; pg8::StaticOrder S; S.init(M, D, G, bid);
                  pg8::EpiBf16Rs E{KB, D, SSQV(ver), 1.0f, 1};
                  pg8::gemm_phase<pg8::EpiBf16Rs, pg8::StaticOrder, true, true>(lds, g, S, E, wave); }
                { pg8::Gemm g{(const bf16_t*)(ws + WS_KV) + (size_t)D * D, hbcur, D, M, D}; pg8::StaticOrder S; S.init(D, M, G, bid);
                  pg8::EpiVt E{VT, 0, SSQV(ver)};
                  pg8::gemm_phase<pg8::EpiVt, pg8::StaticOrder, true, true>(lds, g, S, E, wave); }
            }
            PANEL_BAR();
            {
                pg8::Gemm g{U, (const bf16_t*)(wl + (half ? WL_2OUT : WL_1OUT)), M, D, DFF}; pg8::StaticOrder S; S.init(M, D, G, bid);
                pg8::EpiRes<0> E{hbcur, HB, SSQV(ver + 1), 0.5f, nullptr, nullptr, nullptr};
                pg8::gemm_phase<pg8::EpiRes<0>, pg8::StaticOrder, true, true, true>(lds, g, S, E, wave);
            }
            if (half == 1) {
                pg8::Gemm g{PB + (size_t)l * M * PLE, (const bf16_t*)(wl + WL_P), M, D, PLE}; pg8::StaticOrder S; S.init(M, D, G, bid);
                pg8::EpiBf16Rs E{BQ, D, nullptr, 1.0f, 0};
                pg8::gemm_phase<pg8::EpiBf16Rs, pg8::StaticOrder, true, true>(lds, g, S, E, wave);
            }
            PANEL_BAR();
            ++ver; hbcur = HB;
            if (half == 0) {
                if (l < 2) {
                    { pg8::Gemm g{HB, (const bf16_t*)(ws + WS_CIN + (size_t)l * 4 * MiB), M, 2 * D, D}; pg8::StaticOrder S; S.init(M, 2 * D, G, bid);
                      pg8::EpiGlu<1> E{BQ, D, SSQV(ver), args.in[I_CBIN] + l * 2 * D, D};
                      pg8::gemm_phase<pg8::EpiGlu<1>, pg8::StaticOrder, true, true>(lds, g, S, E, wave); }
                    GRID_BAR();
                    dwconv_phase(lds, BQ, args.in[I_CWDW] + l * 31 * D, args.in[I_CBDW] + l * D, args.in[I_CLNG] + l * D, args.in[I_CLNB] + l * D, BO, wave);
                    GRID_BAR();
                } else {
                    const int j = __builtin_amdgcn_readfirstlane(l - 2);
                    { pg8::Gemm g{HB, (const bf16_t*)(ws + WS_WQ + (size_t)j * 2 * MiB), M, D, D}; pg8::StaticOrder S; S.init(M, D, G, bid);
                      pg8::EpiBf16Rs E{BQ, D, SSQV(ver), QSCALE, 1};
                      pg8::gemm_phase<pg8::EpiBf16Rs, pg8::StaticOrder, true, true>(lds, g, S, E, wave); }
                    GRID_BAR();
                    {
                        int lane_ = LANE_ID(); asm volatile("" : "+v"(lane_));
                        const float a = args.in[I_LQ1][j * 64 + lane_] * args.in[I_LK1][j * 64 + lane_], b2 = args.in[I_LQ2][j * 64 + lane_] * args.in[I_LK2][j * 64 + lane_];
                        const float linit = (j == 0) ? 0.4707130183f : 0.5560582042f;
                        const float post = (j == 0) ? 0.5292869817f : 0.4439417958f;
                        const float lam = __uint_as_float(__builtin_amdgcn_readfirstlane(__float_as_uint(expf(wave_sum(a, lane_)) - expf(wave_sum(b2, lane_)) + linit)));
                        const int vbid = (G % 8 == 0) ? (bid % 8) * (G / 8) + bid / 8 : bid;
                        for (int pi = vbid; pi < 256; pi += G) {
                            const int bh = pi >> 2, s = pi & 3;
#pragma unroll 1
                            for (int uu = 0; uu < 2; ++uu)
                                att::attn_unit(lds, bh >> 3, bh & 7, uu ? s : 7 - s, BQ, KB, VT, BO, args.in[I_RELB], args.in[I_SUBLN] + j * 128, lam, post, grp ? (float*)((unsigned char*)U + (size_t)gid8 * 16 * MiB) + (size_t)gloc * 64 * 512 : (float*)U + (size_t)bid * 64 * 512, wave);
                        }
                    }
                    GRID_BAR();
                }
                {
                    const bf16_t* Bw = (l < 2) ? (const bf16_t*)(ws + WS_COUT + (size_t)l * 2 * MiB) : (const bf16_t*)(ws + WS_WO + (size_t)(l - 2) * 2 * MiB);
                    pg8::Gemm g{BO, Bw, M, D, D}; pg8::StaticOrder S; S.init(M, D, G, bid);
                    pg8::EpiRes<0> E{HB, HB, SSQV(ver + 1), 1.0f, (l < 2) ? args.in[I_CBOUT] + l * D : nullptr, nullptr, nullptr};
                    pg8::gemm_phase<pg8::EpiRes<0>, pg8::StaticOrder, true, true>(lds, g, S, E, wave);
                }
                PANEL_BAR();
                ++ver;
            }
        }
        {
            pg8::Gemm g{HB, (const bf16_t*)(wl + WL_G), M, D, D}; pg8::StaticOrder S; S.init(M, D, G, bid);
            pg8::EpiRes<1> E{HB, BO, SSQV(ver + 1), 1.0f, nullptr, SSQV(ver), BQ};
            pg8::gemm_phase<pg8::EpiRes<1>, pg8::StaticOrder, true, true>(lds, g, S, E, wave);
        }
        if (l == 1) GRID_BAR(); else PANEL_BAR();
        ++ver; hbcur = BO;
    }
    {
        const float* gn = args.in[I_FINALN]; int lane_ = LANE_ID(); asm volatile("" : "+v"(lane_));
        const int mstep = grp ? 1 : ngw;
        for (int m = grp ? (gid8 * 8 + (gloc & 7)) * 256 + (gloc >> 3) * 64 + wave * 8 : gw, mi = 0; m < M && (!grp || mi < 8); m += 2 * mstep, mi += 2) {
            const int m1 = m + mstep; const bool has1 = (m1 < M);
            u32x4 w[2][2];
#pragma unroll
            for (int rr = 0; rr < 2; ++rr) {
                const u32x4* hr = (const u32x4*)(hbcur + (size_t)((rr == 0 || has1) ? m + rr * mstep : m) * D) + lane_;
                w[rr][0] = hr[0]; w[rr][1] = hr[64];
            }
#pragma unroll
            for (int rr = 0; rr < 2; ++rr) {
                if (rr == 1 && !has1) break;
                const int mr = m + rr * mstep;
                float v[16]; float s = 0.f;
#pragma unroll
                for (int j = 0; j < 2; ++j) { const u32x4 ww = w[rr][j];
                    v[8 * j + 0] = __uint_as_float(ww.x << 16); v[8 * j + 1] = __uint_as_float(ww.x & 0xffff0000u); v[8 * j + 2] = __uint_as_float(ww.y << 16); v[8 * j + 3] = __uint_as_float(ww.y & 0xffff0000u);
                    v[8 * j + 4] = __uint_as_float(ww.z << 16); v[8 * j + 5] = __uint_as_float(ww.z & 0xffff0000u); v[8 * j + 6] = __uint_as_float(ww.w << 16); v[8 * j + 7] = __uint_as_float(ww.w & 0xffff0000u); }
#pragma unroll
                for (int i = 0; i < 16; ++i) s += v[i] * v[i];
                const float rstd = 1.0f / sqrtf(wave_sum(s, lane_) * (1.0f / D) + 1e-6f);
#pragma unroll
                for (int j = 0; j < 2; ++j) {
                    const int c = 8 * lane_ + 512 * j; const f32x4 g0 = *(const f32x4*)(gn + c), g1 = *(const f32x4*)(gn + c + 4);
                    f32x4* op = (f32x4*)(out + (size_t)mr * D + c);
                    op[0] = (f32x4){v[8 * j + 0] * rstd * g0[0], v[8 * j + 1] * rstd * g0[1], v[8 * j + 2] * rstd * g0[2], v[8 * j + 3] * rstd * g0[3]};
                    op[1] = (f32x4){v[8 * j + 4] * rstd * g1[0], v[8 * j + 5] * rstd * g1[1], v[8 * j + 6] * rstd * g1[2], v[8 * j + 7] * rstd * g1[3]};
                }
            }
        }
    }
}

extern "C" void kernel_launch(void* const* d_in, const int* in_sizes, int n_in, void* d_out, int out_size, void* d_ws, size_t ws_size, hipStream_t stream) {
    static int grid_blocks = 0;
    if (grid_blocks == 0) {
        if (n_in != 31 || out_size != M * D || ws_size < WS_END) { fprintf(stderr, "kernel_launch: unexpected shapes (n_in %d out %d ws %zu need %zu)\n", n_in, out_size, ws_size, (size_t)WS_END); grid_blocks = -1; return; }
        int dev = 0, cus = 0, per_cu = 0;
        hipGetDevice(&dev);
        hipDeviceGetAttribute(&cus, hipDeviceAttributeMultiprocessorCount, dev);
        hipFuncSetAttribute((const void*)fwd_megakernel, hipFuncAttributeMaxDynamicSharedMemorySize, LDS_BYTES);
        hipOccupancyMaxActiveBlocksPerMultiprocessor(&per_cu, (const void*)fwd_megakernel, NTHREADS, LDS_BYTES);
        if (per_cu < 1) per_cu = 1;
        if (per_cu > 1) per_cu = 1;
        grid_blocks = cus * per_cu;
        (void)hipGetLastError();
    }
    if (grid_blocks < 0) return;
    Args a{};
    for (int i = 0; i < 31; ++i) a.in[i] = (const float*)d_in[i];
    a.out = (float*)d_out; a.ws = (unsigned char*)d_ws; a.pad = 0ull;
    void* kargs[] = {&a};
    hipError_t e = hipLaunchCooperativeKernel((const void*)fwd_megakernel, dim3(grid_blocks), dim3(NTHREADS), kargs, LDS_BYTES, stream);
    if (e != hipSuccess) fprintf(stderr, "cooperative launch failed: %s (grid %d)\n", hipGetErrorString(e), grid_blocks);
}
```
